# Optimizing an MI355X kernel written in HIP

```python
import jax, jax.numpy as jnp
from jax import lax
import numpy as np

D_MODEL = 2048
BATCH = 2
SEQ = 4096
DEPTH = 1

CHUNK = 64
N_MEM = 256
MIX_WIDTH = D_MODEL
CONV_CH = MIX_WIDTH // 2
CONV_WIDTH = 31
SGU_CH = MIX_WIDTH - CONV_CH
SGU_GROUPS = 8
SGU_GROUP_DIM = SGU_CH // SGU_GROUPS
GMLP_CHUNK = 128
XA_HEADS = 4
XA_HEAD_DIM = D_MODEL // XA_HEADS
D_FF = 5632
MACARON_SCALE = 0.5
RMS_EPS = 1e-6
LN_EPS = 1e-5

kernel_name = "hybrid_conformer_conv_gmlp_macaron"


def rms_norm(x, g):
    xf = x.astype(jnp.float32)
    y = xf * lax.rsqrt(jnp.mean(xf * xf, axis=-1, keepdims=True) + RMS_EPS)
    return (y * g.astype(jnp.float32)).astype(x.dtype)


def layer_norm(x, g, b):
    xf = x.astype(jnp.float32)
    mu = jnp.mean(xf, axis=-1, keepdims=True)
    xc = xf - mu
    y = xc * lax.rsqrt(jnp.mean(xc * xc, axis=-1, keepdims=True) + LN_EPS)
    return (y * g.astype(jnp.float32) + b.astype(jnp.float32)).astype(x.dtype)


def swiglu_ffn(h, w_in, w_out):
    gate, up = jnp.split(h @ w_in, 2, axis=-1)
    return (jax.nn.silu(gate) * up) @ w_out


def conv_module_group(val, gate, conv_w, conv_b, ln_g, ln_b):
    a = val * jax.nn.sigmoid(gate)
    y = lax.conv_general_dilated(
        a, conv_w[:, None, :],
        window_strides=(1,),
        padding=[(CONV_WIDTH - 1, 0)],
        dimension_numbers=("NWC", "WIO", "NWC"),
        feature_group_count=CONV_CH)
    y = y + conv_b
    y = layer_norm(y, ln_g, ln_b)
    return jax.nn.silu(y)


def spatial_gating_group(u, v, ln_g, ln_b, w_s, b_s):
    B, S, _ = u.shape
    n_chunks = S // GMLP_CHUNK
    v = layer_norm(v, ln_g, ln_b)
    blk = jnp.arange(GMLP_CHUNK) // CHUNK
    mask = blk[None, :] <= blk[:, None]
    w = jnp.where(mask[None], w_s, jnp.zeros((), w_s.dtype))
    vh = v.reshape(B, n_chunks, GMLP_CHUNK, SGU_GROUPS, SGU_GROUP_DIM)
    mixed = jnp.einsum("hij,bnjhc->bnihc", w, vh)
    mixed = mixed + jnp.transpose(b_s)[None, None, :, :, None]
    return u * mixed.reshape(B, S, SGU_CH)


def memory_cross_attention(h, mem_n, w_q, w_kv, w_o):
    B, S, _ = h.shape
    M = mem_n.shape[1]
    q = (h @ w_q).reshape(B, S, XA_HEADS, XA_HEAD_DIM)
    k, v = jnp.split(mem_n @ w_kv, 2, axis=-1)
    k = k.reshape(B, M, XA_HEADS, XA_HEAD_DIM)
    v = v.reshape(B, M, XA_HEADS, XA_HEAD_DIM)
    s = jnp.einsum("bshd,bmhd->bhsm", q, k).astype(jnp.float32) * (XA_HEAD_DIM ** -0.5)
    p = jax.nn.softmax(s, axis=-1).astype(v.dtype)
    o = jnp.einsum("bhsm,bmhd->bshd", p, v).reshape(B, S, D_MODEL)
    return o @ w_o


def setup_inputs(seed: int = 0) -> dict:
    key = jax.random.key(seed)
    ks = jax.random.split(key, 32)
    L, D, F = DEPTH, D_MODEL, D_FF

    def nrm(k, shape, fan_in):
        return jax.random.normal(k, shape, jnp.float32) * (fan_in ** -0.5)

    def gain(k, shape):
        return 1.0 + 0.05 * jax.random.normal(k, shape, jnp.float32)

    def bias(k, shape, s=0.02):
        return s * jax.random.normal(k, shape, jnp.float32)

    return {
        "x": jax.random.normal(ks[0], (BATCH, SEQ, D), jnp.float32),
        "mem": jax.random.normal(ks[1], (BATCH, N_MEM, D), jnp.float32),
        "ffn1_norm": gain(ks[2], (L, D)),
        "ffn1_w_in": nrm(ks[3], (L, D, 2 * F), D),
        "ffn1_w_out": nrm(ks[4], (L, F, D), F),
        "mix_norm": gain(ks[5], (L, D)),
        "w_mix_in": nrm(ks[6], (L, D, 2 * CONV_CH + 2 * SGU_CH), D),
        "conv_w": nrm(ks[7], (L, CONV_WIDTH, CONV_CH), CONV_WIDTH),
        "conv_b": bias(ks[8], (L, CONV_CH)),
        "conv_ln_g": gain(ks[9], (L, CONV_CH)),
        "conv_ln_b": bias(ks[10], (L, CONV_CH)),
        "sgu_ln_g": gain(ks[11], (L, SGU_CH)),
        "sgu_ln_b": bias(ks[12], (L, SGU_CH)),
        "sgu_w": nrm(ks[13], (L, SGU_GROUPS, GMLP_CHUNK, GMLP_CHUNK), GMLP_CHUNK),
        "sgu_b": 1.0 + 0.1 * jax.random.normal(ks[14], (L, SGU_GROUPS, GMLP_CHUNK), jnp.float32),
        "out_norm_conv": gain(ks[15], (L, CONV_CH)),
        "out_norm_sgu": gain(ks[16], (L, SGU_CH)),
        "w_mix_out": nrm(ks[17], (L, MIX_WIDTH, D), MIX_WIDTH),
        "xattn_norm": gain(ks[18], (L, D)),
        "mem_norm": gain(ks[19], (L, D)),
        "w_q": nrm(ks[20], (L, D, D), D),
        "w_kv": nrm(ks[21], (L, D, 2 * D), D),
        "w_o": nrm(ks[22], (L, D, D), D),
        "ffn2_norm": gain(ks[23], (L, D)),
        "ffn2_w_in": nrm(ks[24], (L, D, 2 * F), D),
        "ffn2_w_out": nrm(ks[25], (L, F, D), F),
        "final_norm": gain(ks[26], (D,)),
    }


def reference(x, mem, ffn1_norm, ffn1_w_in, ffn1_w_out, mix_norm, w_mix_in,
              conv_w, conv_b, conv_ln_g, conv_ln_b, sgu_ln_g, sgu_ln_b, sgu_w, sgu_b,
              out_norm_conv, out_norm_sgu, w_mix_out, xattn_norm, mem_norm,
              w_q, w_kv, w_o, ffn2_norm, ffn2_w_in, ffn2_w_out, final_norm):
    split_at = [CONV_CH, 2 * CONV_CH, 2 * CONV_CH + SGU_CH]
    for l in range(DEPTH):
        h = rms_norm(x, ffn1_norm[l])
        x = x + MACARON_SCALE * swiglu_ffn(h, ffn1_w_in[l], ffn1_w_out[l])

        h = rms_norm(x, mix_norm[l])
        p = h @ w_mix_in[l]
        a_val, a_gate, g_u, g_v = jnp.split(p, split_at, axis=-1)
        ya = conv_module_group(a_val, a_gate, conv_w[l], conv_b[l], conv_ln_g[l], conv_ln_b[l])
        yb = spatial_gating_group(jax.nn.gelu(g_u, approximate=False),
                                  jax.nn.gelu(g_v, approximate=False),
                                  sgu_ln_g[l], sgu_ln_b[l], sgu_w[l], sgu_b[l])
        y = jnp.concatenate([rms_norm(ya, out_norm_conv[l]),
                             rms_norm(yb, out_norm_sgu[l])], axis=-1)
        x = x + y @ w_mix_out[l]

        h = rms_norm(x, xattn_norm[l])
        mem_n = rms_norm(mem, mem_norm[l])
        x = x + memory_cross_attention(h, mem_n, w_q[l], w_kv[l], w_o[l])

        h = rms_norm(x, ffn2_norm[l])
        x = x + MACARON_SCALE * swiglu_ffn(h, ffn2_w_in[l], ffn2_w_out[l])
    return rms_norm(x, final_norm)
```

```cpp
#include <hip/hip_runtime.h>
#include <hip/hip_cooperative_groups.h>
#include <cstdio>
#include <cstdint>
namespace cg = cooperative_groups;

#ifndef MK_PROBE_MASK
#define MK_PROBE_MASK 0
#endif
#ifndef MK_MULTI
#define MK_MULTI 0
#endif

#define LAS __attribute__((address_space(3)))
typedef unsigned short bf16_t;
typedef short bf16x8 __attribute__((ext_vector_type(8)));
typedef float f32x4 __attribute__((ext_vector_type(4)));
typedef float f32x2 __attribute__((ext_vector_type(2)));
typedef unsigned u32x4 __attribute__((ext_vector_type(4)));
typedef unsigned u32x2 __attribute__((ext_vector_type(2)));

constexpr int T = 8192, D = 2048, FF = 5632, SEQ = 4096, NMEM = 256, CCH = 1024, NPART = 32;
constexpr float RMS_EPS = 1e-6f, LN_EPS = 1e-5f;
constexpr int NWAVES = 8, NTHR = 512;
constexpr int RING_BYTES = 131072, LDS_BYTES = 147456;
constexpr int NPHASE = 13;

constexpr size_t MiB = 1u << 20;
constexpr size_t WS_W1IN = 0, WS_W1OUT = 44 * MiB, WS_W2IN = 66 * MiB, WS_W2OUT = 110 * MiB, WS_WMIXIN = 132 * MiB, WS_WMIXOUT = 148 * MiB,
                 WS_WQ = 156 * MiB, WS_WKV = 164 * MiB, WS_WO = 180 * MiB, WS_WSGU = 188 * MiB, WS_MEMN = 189 * MiB, WS_KMAT = 191 * MiB,
                 WS_VT = 193 * MiB, WS_PART = 195 * MiB, WS_VSTAT = 196 * MiB, WS_XB = 197 * MiB, WS_XR = 229 * MiB, WS_ACT = 293 * MiB,
                 WS_CTL = 381 * MiB, WS_END = 382 * MiB;
constexpr size_t CTL_ZERO_BYTES = 32768;
constexpr size_t WS_AB = WS_ACT, WS_UB = WS_ACT + 16 * MiB, WS_VB = WS_ACT + 32 * MiB, WS_Y = WS_ACT + 48 * MiB;
constexpr size_t WS_Q = WS_ACT, WS_P = WS_ACT + 32 * MiB, WS_O = WS_ACT + 48 * MiB;

__device__ __forceinline__ unsigned cvt_pk_bf16(float lo, float hi) { unsigned r; asm volatile("v_cvt_pk_bf16_f32 %0, %1, %2" : "=v"(r) : "v"(lo), "v"(hi)); return r; }
__device__ __forceinline__ void st16_wt(void* p, u32x4 v) { asm volatile("global_store_dwordx4 %0, %1, off sc1\n\ts_nop 1" : : "v"(p), "v"(v) : "memory"); }
__device__ __forceinline__ void st8_wt(void* p, u32x2 v) { asm volatile("global_store_dwordx2 %0, %1, off sc1\n\ts_nop 1" : : "v"(p), "v"(v) : "memory"); }
__device__ __forceinline__ float bf_lo(unsigned u) { return __uint_as_float(u << 16); }
__device__ __forceinline__ float bf_hi(unsigned u) { return __uint_as_float(u & 0xffff0000u); }
__device__ __forceinline__ float wave_sum(float v) {
#pragma unroll
    for (int o = 1; o < 64; o <<= 1) v += __shfl_xor(v, o);
    return v;
}
__device__ __forceinline__ float fast_exp2(float x) { return __builtin_amdgcn_exp2f(x); }
__device__ __forceinline__ float fast_rcp(float x) { return __builtin_amdgcn_rcpf(x); }
__device__ __forceinline__ float sigmoidf_(float x) { return fast_rcp(1.0f + fast_exp2(-1.4426950408889634f * x)); }
__device__ __forceinline__ f32x2 gelu_pk(f32x2 v) {
    const f32x2 av = __builtin_elementwise_abs(v), d = av * 0.2316418882f + 1.0f;
    f32x2 t; t.x = __builtin_amdgcn_rcpf(d.x); t.y = __builtin_amdgcn_rcpf(d.y);
    f32x2 q = t * 0.5307027145f + (-0.7265760135f); q = q * t + 0.7107068705f; q = q * t + (-0.142248368f); q = q * t + 0.127414796f; q = q * t;
    const f32x2 s = (v * v) * (-0.72134752044f);
    f32x2 e; e.x = __builtin_amdgcn_exp2f(s.x); e.y = __builtin_amdgcn_exp2f(s.y);
    const f32x2 m = v * (q * e), r = v - m;
    f32x2 o; o.x = v.x < 0.f ? m.x : r.x; o.y = v.y < 0.f ? m.y : r.y; return o;
}
__device__ __forceinline__ f32x4 gelu4(f32x4 v) { f32x2 a = gelu_pk((f32x2){v[0], v[1]}), b = gelu_pk((f32x2){v[2], v[3]}); return (f32x4){a.x, a.y, b.x, b.y}; }

namespace pg8 {
constexpr int BM = 256, BK = 64, HALF = 128, HTB = HALF * BK * 2, STAGE_BYTES = 8 * HTB, NXCD = 8, WGM = 8;
__host__ __device__ __forceinline__ int lds_byte(int r, int c) { const int st = (r >> 4) * 2 + (c >> 5), rr = r & 15, cc = c & 31, ob = rr * 64 + cc * 2; return st * 1024 + (ob ^ (((ob >> 9) & 1) << 5)); }
__host__ __device__ __forceinline__ void stage_rc(int b, int& R, int& C) { const int st = b / 1024, sb = b % 1024, swz = sb ^ (((sb >> 9) & 1) << 5); R = (st >> 1) * 16 + swz / 64; C = (st & 1) * 32 + (swz % 64) / 2; }
__host__ __device__ __forceinline__ int perm32(int rho) { const int n = rho >> 4, i = rho & 15; return 8 * (i >> 2) + 4 * n + (i & 3); }

struct Unit { int pm, pn; unsigned aoff, boff; };
struct Gemm { const bf16_t* A; const bf16_t* Bt; int lda, ldb, K; };

struct StaticOrder {
    int nM, nN, nwg, G, c;
    __device__ __forceinline__ void init(int M, int N, int G_, int c_) { nM = M / BM; nN = N / BM; nwg = nM * nN; G = G_; c = c_; }
    __device__ __forceinline__ bool next(int i, int& pm, int& pn) const {
        const long L = (long)i * G + c; if (L >= nwg) return false;
        int wgid = (int)L; { const int q = nwg / NXCD, r = nwg % NXCD, xcd = wgid % NXCD, off = wgid / NXCD; wgid = (xcd < r ? xcd * (q + 1) : r * (q + 1) + (xcd - r) * q) + off; }
        const int nig = WGM * nN, gid = wgid / nig, fm = gid * WGM, gsz = (nM - fm) < WGM ? (nM - fm) : WGM;
        pm = fm + ((wgid % nig) % gsz); pn = (wgid % nig) / gsz; return true;
    }
};
struct PlainOrder {
    StaticOrder so; int lda, ldb;
    __device__ void init(int M, int N, int G, int c, int lda_, int ldb_) { so.init(M, N, G, c); lda = lda_; ldb = ldb_; }
    __device__ bool next(int i, Unit& u) const { int pm, pn; if (!so.next(i, pm, pn)) return false; u.pm = pm; u.pn = pn; u.aoff = (unsigned)pm * BM * lda; u.boff = (unsigned)pn * BM * ldb; return true; }
};
struct BatchBOrder {
    StaticOrder so; int lda, ldb; unsigned bstride;
    __device__ __forceinline__ void init(int M, int N, int G, int c, int lda_, int ldb_, unsigned bs) { so.init(M, N, G, c); lda = lda_; ldb = ldb_; bstride = bs; }
    __device__ __forceinline__ bool next(int i, Unit& u) const { int pm, pn; if (!so.next(i, pm, pn)) return false; u.pm = pm; u.pn = pn; u.aoff = (unsigned)pm * BM * lda; u.boff = (unsigned)(pm >> 4) * bstride + (unsigned)pn * BM * ldb; return true; }
};
struct MixOrder {
    StaticOrder so; int lda, ldb;
    __device__ __forceinline__ void init(int M, int N, int G, int c, int lda_, int ldb_) { so.init(M, N, G, c); lda = lda_; ldb = ldb_; }
    __device__ __forceinline__ bool next(int i, Unit& u) const { int pm, pn; if (!so.next(i, pm, pn)) return false; u.pm = pm; u.pn = ((pn & 12) == 4 || (pn & 12) == 8) ? (pn ^ 12) : pn; u.aoff = (unsigned)pm * BM * lda; u.boff = (unsigned)pn * BM * ldb; return true; }
};
struct OneUnit { Unit u; __device__ bool next(int i, Unit& o) const { if (i) return false; o = u; return true; } };
struct PVOrder {
    int G, c;
    __device__ bool next(int i, Unit& u) const { const int L = i * G + c; if (L >= 256) return false; const int pn = L & 1, h = (L >> 1) & 3, pm = L >> 3;
        u.pm = pm; u.pn = 2 * h + pn; u.aoff = (unsigned)pm * 256 * 1024 + h * 256; u.boff = (unsigned)(h * 512 + pn * 256) * 512 + (pm >> 4) * 256; return true; }
};

__device__ __forceinline__ void load_rstd(const float* part, int row0, int fq, float (&rs)[2][4]) {
#pragma unroll
    for (int ai = 0; ai < 2; ++ai)
#pragma unroll
        for (int m = 0; m < 4; ++m) { const float* p = part + (size_t)(row0 + ai * HALF + m * 16) * NPART + fq * 8;
            const f32x4 a = *(const f32x4*)p, b = *(const f32x4*)(p + 4); float s = ((a[0] + a[1]) + (a[2] + a[3])) + ((b[0] + b[1]) + (b[2] + b[3]));
            s += __shfl_xor(s, 16); s += __shfl_xor(s, 32); rs[ai][m] = rsqrtf(s * (1.0f / D) + RMS_EPS); }
}

struct EpiBf16S {
    static constexpr bool PERM = true, AFTER_DRAIN = false;
    bf16_t* O; int ldc; const float* part; float mul;
    __device__ __forceinline__ void operator()(const f32x4 (&acc)[2][2][4][2], const Unit& u, int wr, int wc, int fr, int fq) const {
        const int row0 = u.pm * BM + wr * 64 + fr, col0 = u.pn * BM + wc * 32 + 8 * fq;
        float rs[2][4];
        if (part) load_rstd(part, row0, fq, rs);
#pragma unroll
        for (int ai = 0; ai < 2; ++ai)
#pragma unroll
            for (int m = 0; m < 4; ++m) { const float sc = part ? rs[ai][m] * mul : mul; bf16_t* rowp = O + (size_t)(row0 + ai * HALF + m * 16) * ldc + col0;
#pragma unroll
                for (int bj = 0; bj < 2; ++bj) { const f32x4 v0 = acc[ai][bj][m][0] * sc, v1 = acc[ai][bj][m][1] * sc; u32x4 w;
                    w.x = cvt_pk_bf16(v0[0], v0[1]); w.y = cvt_pk_bf16(v0[2], v0[3]); w.z = cvt_pk_bf16(v1[0], v1[1]); w.w = cvt_pk_bf16(v1[2], v1[3]);
                    st16_wt(rowp + bj * HALF, w); } }
    }
};
struct EpiBf16Pub {
    static constexpr bool PERM = true, AFTER_DRAIN = false;
    bf16_t* O; int ldc; unsigned* cnt;
    __device__ __forceinline__ void operator()(const f32x4 (&acc)[2][2][4][2], const Unit& u, int wr, int wc, int fr, int fq) const {
        const int row0 = u.pm * BM + wr * 64 + fr, col0 = u.pn * BM + wc * 32 + 8 * fq;
#pragma unroll
        for (int ai = 0; ai < 2; ++ai)
#pragma unroll
            for (int m = 0; m < 4; ++m) { bf16_t* rowp = O + (size_t)(row0 + ai * HALF + m * 16) * ldc + col0;
#pragma unroll
                for (int bj = 0; bj < 2; ++bj) { const f32x4 v0 = acc[ai][bj][m][0], v1 = acc[ai][bj][m][1]; u32x4 w;
                    w.x = cvt_pk_bf16(v0[0], v0[1]); w.y = cvt_pk_bf16(v0[2], v0[3]); w.z = cvt_pk_bf16(v1[0], v1[1]); w.w = cvt_pk_bf16(v1[2], v1[3]);
                    st16_wt(rowp + bj * HALF, w); } }
        asm volatile("s_waitcnt vmcnt(0)" ::: "memory");
        if ((threadIdx.x & 63) == 0) __hip_atomic_fetch_add(cnt, 1u, __ATOMIC_RELAXED, __HIP_MEMORY_SCOPE_AGENT);
    }
};
struct EpiSwiGLU {
    static constexpr bool PERM = true, AFTER_DRAIN = false;
    bf16_t* O; const float* part;
    __device__ __forceinline__ void operator()(const f32x4 (&acc)[2][2][4][2], const Unit& u, int wr, int wc, int fr, int fq) const {
        const int row0 = u.pm * BM + wr * 64 + fr, col0 = u.pn * HALF + wc * 32 + 8 * fq;
        float rs[2][4]; load_rstd(part, row0, fq, rs);
#pragma unroll
        for (int ai = 0; ai < 2; ++ai)
#pragma unroll
            for (int m = 0; m < 4; ++m) { const float sc = rs[ai][m]; f32x4 o[2];
#pragma unroll
                for (int n = 0; n < 2; ++n) { const f32x4 g = acc[ai][0][m][n] * sc, up = acc[ai][1][m][n] * sc;
#pragma unroll
                    for (int e = 0; e < 4; ++e) o[n][e] = g[e] * sigmoidf_(g[e]) * up[e]; }
                u32x4 w; w.x = cvt_pk_bf16(o[0][0], o[0][1]); w.y = cvt_pk_bf16(o[0][2], o[0][3]); w.z = cvt_pk_bf16(o[1][0], o[1][1]); w.w = cvt_pk_bf16(o[1][2], o[1][3]);
                st16_wt(O + (size_t)(row0 + ai * HALF + m * 16) * FF + col0, w); }
    }
};
struct EpiMixIn {
    static constexpr bool PERM = true, AFTER_DRAIN = false;
    bf16_t *AB, *UB, *VB; float* vstat; const float* part;
    __device__ __forceinline__ void operator()(const f32x4 (&acc)[2][2][4][2], const Unit& u, int wr, int wc, int fr, int fq) const {
        const int row0 = u.pm * BM + wr * 64 + fr;
        float rs[2][4]; load_rstd(part, row0, fq, rs);
        if (u.pn < 8) {
            const int col0 = u.pn * HALF + wc * 32 + 8 * fq;
#pragma unroll
            for (int ai = 0; ai < 2; ++ai)
#pragma unroll
                for (int m = 0; m < 4; ++m) { const float sc = rs[ai][m]; f32x4 o[2];
#pragma unroll
                    for (int n = 0; n < 2; ++n) { const f32x4 v = acc[ai][0][m][n] * sc, g = acc[ai][1][m][n] * sc;
#pragma unroll
                        for (int e = 0; e < 4; ++e) o[n][e] = v[e] * sigmoidf_(g[e]); }
                    u32x4 w; w.x = cvt_pk_bf16(o[0][0], o[0][1]); w.y = cvt_pk_bf16(o[0][2], o[0][3]); w.z = cvt_pk_bf16(o[1][0], o[1][1]); w.w = cvt_pk_bf16(o[1][2], o[1][3]);
                    st16_wt(AB + (size_t)(row0 + ai * HALF + m * 16) * CCH + col0, w); }
        } else {
            const bool isv = u.pn >= 12; bf16_t* dst = isv ? VB : UB; const int tq = isv ? u.pn - 12 : u.pn - 8;
            const int col0 = tq * BM + wc * 32 + 8 * fq;
#pragma unroll
            for (int ai = 0; ai < 2; ++ai)
#pragma unroll
                for (int m = 0; m < 4; ++m) { const float sc = rs[ai][m]; const int row = row0 + ai * HALF + m * 16; float s1 = 0.f, s2 = 0.f;
#pragma unroll
                    for (int bj = 0; bj < 2; ++bj) { const f32x4 v0 = gelu4(acc[ai][bj][m][0] * sc), v1 = gelu4(acc[ai][bj][m][1] * sc);
                        s1 += ((v0[0] + v0[1]) + (v0[2] + v0[3])) + ((v1[0] + v1[1]) + (v1[2] + v1[3]));
                        s2 += ((v0[0] * v0[0] + v0[1] * v0[1]) + (v0[2] * v0[2] + v0[3] * v0[3])) + ((v1[0] * v1[0] + v1[1] * v1[1]) + (v1[2] * v1[2] + v1[3] * v1[3]));
                        u32x4 w; w.x = cvt_pk_bf16(v0[0], v0[1]); w.y = cvt_pk_bf16(v0[2], v0[3]); w.z = cvt_pk_bf16(v1[0], v1[1]); w.w = cvt_pk_bf16(v1[2], v1[3]);
                        st16_wt(dst + (size_t)row * CCH + col0 + bj * HALF, w); }
                    if (isv) { s1 += __shfl_xor(s1, 16); s1 += __shfl_xor(s1, 32); s2 += __shfl_xor(s2, 16); s2 += __shfl_xor(s2, 32);
                        if (fq == 0) *(f32x2*)(vstat + ((size_t)row * 16 + tq * 4 + wc) * 2) = (f32x2){s1, s2}; } }
        }
    }
};
struct EpiResid {
    static constexpr bool PERM = true, AFTER_DRAIN = false;
    bf16_t* XB; float* part; float alpha;
    __device__ __forceinline__ void operator()(const f32x4 (&acc)[2][2][4][2], const Unit& u, int wr, int wc, int fr, int fq) const {
        const int row0 = u.pm * BM + wr * 64 + fr, col0 = u.pn * BM + wc * 32 + 8 * fq;
#pragma unroll
        for (int ai = 0; ai < 2; ++ai)
#pragma unroll
            for (int m = 0; m < 4; ++m) { const int row = row0 + ai * HALF + m * 16; bf16_t* rowp = XB + (size_t)row * D + col0; float ss = 0.f;
#pragma unroll
                for (int bj = 0; bj < 2; ++bj) { const u32x4 r = *(const u32x4*)(rowp + bj * HALF);
                    const f32x4 o0 = (f32x4){bf_lo(r.x), bf_hi(r.x), bf_lo(r.y), bf_hi(r.y)} + acc[ai][bj][m][0] * alpha, o1 = (f32x4){bf_lo(r.z), bf_hi(r.z), bf_lo(r.w), bf_hi(r.w)} + acc[ai][bj][m][1] * alpha;
                    ss += ((o0[0] * o0[0] + o0[1] * o0[1]) + (o0[2] * o0[2] + o0[3] * o0[3])) + ((o1[0] * o1[0] + o1[1] * o1[1]) + (o1[2] * o1[2] + o1[3] * o1[3]));
                    u32x4 w; w.x = cvt_pk_bf16(o0[0], o0[1]); w.y = cvt_pk_bf16(o0[2], o0[3]); w.z = cvt_pk_bf16(o1[0], o1[1]); w.w = cvt_pk_bf16(o1[2], o1[3]);
                    st16_wt(rowp + bj * HALF, w); }
                ss += __shfl_xor(ss, 16); ss += __shfl_xor(ss, 32);
                if (fq == 0) part[(size_t)row * NPART + u.pn * 4 + wc] = ss; }
    }
};
struct EpiFinal {
    static constexpr bool PERM = true, AFTER_DRAIN = false;
    const bf16_t* XB; float* part; unsigned* cnt; const float* gain; float* out; float alpha; LAS float* R;
    __device__ __forceinline__ void operator()(f32x4 (&acc)[2][2][4][2], const Unit& u, int wr, int wc, int fr, int fq) const {
        const int row0 = u.pm * BM + wr * 64 + fr, col0 = u.pn * BM + wc * 32 + 8 * fq;
#pragma unroll
        for (int ai = 0; ai < 2; ++ai)
#pragma unroll
            for (int m = 0; m < 4; ++m) { const int row = row0 + ai * HALF + m * 16; const bf16_t* rowp = XB + (size_t)row * D + col0; float ss = 0.f;
#pragma unroll
                for (int bj = 0; bj < 2; ++bj) { const u32x4 r = *(const u32x4*)(rowp + bj * HALF);
                    const f32x4 o0 = (f32x4){bf_lo(r.x), bf_hi(r.x), bf_lo(r.y), bf_hi(r.y)} + acc[ai][bj][m][0] * alpha, o1 = (f32x4){bf_lo(r.z), bf_hi(r.z), bf_lo(r.w), bf_hi(r.w)} + acc[ai][bj][m][1] * alpha;
                    ss += ((o0[0] * o0[0] + o0[1] * o0[1]) + (o0[2] * o0[2] + o0[3] * o0[3])) + ((o1[0] * o1[0] + o1[1] * o1[1]) + (o1[2] * o1[2] + o1[3] * o1[3]));
                    acc[ai][bj][m][0] = o0; acc[ai][bj][m][1] = o1; }
                ss += __shfl_xor(ss, 16); ss += __shfl_xor(ss, 32);
                if (fq == 0) __hip_atomic_store(part + (size_t)row * NPART + u.pn * 4 + wc, ss, __ATOMIC_RELAXED, __HIP_MEMORY_SCOPE_AGENT); }
        asm volatile("s_waitcnt vmcnt(0)" ::: "memory");
        unsigned* c = cnt + 64 * u.pm;
        if ((threadIdx.x & 63) == 0) __hip_atomic_fetch_add(c, 1u, __ATOMIC_RELAXED, __HIP_MEMORY_SCOPE_AGENT);
        if (threadIdx.x < 256) {
            unsigned sp = 0;
            while ((unsigned)__builtin_amdgcn_readfirstlane(__hip_atomic_load(c, __ATOMIC_RELAXED, __HIP_MEMORY_SCOPE_AGENT)) < 64u) { __builtin_amdgcn_s_sleep(4); if (++sp > (1u << 21)) break; }
            __builtin_amdgcn_fence(__ATOMIC_ACQUIRE, "agent");
            const unsigned long long* p = (const unsigned long long*)(part + (size_t)(u.pm * BM + threadIdx.x) * NPART); float s = 0.f;
#pragma unroll
            for (int j = 0; j < 16; ++j) { const unsigned long long w = __hip_atomic_load(p + j, __ATOMIC_RELAXED, __HIP_MEMORY_SCOPE_AGENT); s += __uint_as_float((unsigned)w) + __uint_as_float((unsigned)(w >> 32)); }
            R[threadIdx.x] = rsqrtf(s * (1.0f / D) + RMS_EPS);
        }
        asm volatile("s_waitcnt vmcnt(0) lgkmcnt(0)" ::: "memory"); __builtin_amdgcn_s_barrier(); asm volatile("" ::: "memory");
#pragma unroll
        for (int ai = 0; ai < 2; ++ai)
#pragma unroll
            for (int m = 0; m < 4; ++m) { const int rl = ai * HALF + wr * 64 + m * 16 + fr; const float rstd = R[rl]; float* orow = out + (size_t)(u.pm * BM + rl) * D + col0;
#pragma unroll
                for (int bj = 0; bj < 2; ++bj) { const f32x4 g0 = *(const f32x4*)(gain + col0 + bj * HALF), g1 = *(const f32x4*)(gain + col0 + bj * HALF + 4);
                    *(f32x4*)(orow + bj * HALF) = acc[ai][bj][m][0] * rstd * g0; *(f32x4*)(orow + bj * HALF + 4) = acc[ai][bj][m][1] * rstd * g1; } }
    }
};
struct EpiSoftmax {
    static constexpr bool PERM = true, AFTER_DRAIN = true;
    bf16_t* P; const float* part; float mul;
    __device__ __forceinline__ void fused(f32x4 (&acc)[2][2][4][2], const Unit& u, int wr, int wc, int fr, int fq, LAS unsigned char* lds, int wid, int lane) const {
        LAS f32x2* X = (LAS f32x2*)lds;
        float mw[2][4]; float rs[2][4]; load_rstd(part, u.pm * BM + wr * 64 + fr, fq, rs);
#pragma unroll
        for (int ai = 0; ai < 2; ++ai)
#pragma unroll
            for (int m = 0; m < 4; ++m) {
                float mx = -3.0e38f;
#pragma unroll
                for (int bj = 0; bj < 2; ++bj)
#pragma unroll
                    for (int n = 0; n < 2; ++n) { const f32x4 a = acc[ai][bj][m][n] * (rs[ai][m] * mul); acc[ai][bj][m][n] = a; mx = fmaxf(mx, fmaxf(fmaxf(a[0], a[1]), fmaxf(a[2], a[3]))); }
                mx = fmaxf(mx, __shfl_xor(mx, 16)); mx = fmaxf(mx, __shfl_xor(mx, 32));
                float s = 0.f;
#pragma unroll
                for (int bj = 0; bj < 2; ++bj)
#pragma unroll
                    for (int n = 0; n < 2; ++n) { f32x4 a = acc[ai][bj][m][n];
#pragma unroll
                        for (int e = 0; e < 4; ++e) { a[e] = fast_exp2(a[e] - mx); s += a[e]; }
                        acc[ai][bj][m][n] = a; }
                s += __shfl_xor(s, 16); s += __shfl_xor(s, 32);
                mw[ai][m] = mx;
                if (fq == 0) X[(ai * HALF + wr * 64 + m * 16 + fr) * 4 + wc] = (f32x2){mx, s};
            }
        asm volatile("s_waitcnt lgkmcnt(0)" ::: "memory"); __builtin_amdgcn_s_barrier(); asm volatile("" ::: "memory");
#pragma unroll
        for (int ai = 0; ai < 2; ++ai)
#pragma unroll
            for (int m = 0; m < 4; ++m) { const int r = ai * HALF + wr * 64 + m * 16 + fr;
                const f32x4 p01 = *(const LAS f32x4*)(X + r * 4), p23 = *(const LAS f32x4*)(X + r * 4 + 2);
                const float M = fmaxf(fmaxf(p01[0], p01[2]), fmaxf(p23[0], p23[2]));
                const float tot = (p01[1] * fast_exp2(p01[0] - M) + p01[3] * fast_exp2(p01[2] - M)) + (p23[1] * fast_exp2(p23[0] - M) + p23[3] * fast_exp2(p23[2] - M));
                const float f = fast_exp2(mw[ai][m] - M) / tot;
                bf16_t* rowp = P + (size_t)(u.pm * BM + r) * 1024 + u.pn * BM + wc * 32 + 8 * fq;
#pragma unroll
                for (int bj = 0; bj < 2; ++bj) { const f32x4 v0 = acc[ai][bj][m][0] * f, v1 = acc[ai][bj][m][1] * f; u32x4 w;
                    w.x = cvt_pk_bf16(v0[0], v0[1]); w.y = cvt_pk_bf16(v0[2], v0[3]); w.z = cvt_pk_bf16(v1[0], v1[1]); w.w = cvt_pk_bf16(v1[2], v1[3]);
                    st16_wt(rowp + bj * HALF, w); } }
        asm volatile("s_waitcnt lgkmcnt(0)" ::: "memory"); __builtin_amdgcn_s_barrier(); asm volatile("" ::: "memory");
    }
};

template <class Epi, class Sched, bool ALIGN_EPI>
__device__ __forceinline__ void gemm_phase(LAS unsigned char* lds, const Gemm g, const Sched& S, const Epi& E) {
    const int tid = threadIdx.x, wid = __builtin_amdgcn_readfirstlane(tid >> 6), lane = tid & 63, wr = wid >> 2, wc = wid & 3, fr = lane & 15, fq = lane >> 4;
    const int K = g.K, nt = K / BK;
    unsigned voffA[2], voffB[2];
#pragma unroll
    for (int i = 0; i < 2; ++i) { int R, C; stage_rc(tid * 16 + i * 8192, R, C); const int Rb = Epi::PERM ? ((R & ~31) + perm32(R & 31)) : R;
        voffA[i] = (unsigned)(R * g.lda + C) * 2u; voffB[i] = (unsigned)(Rb * g.ldb + C) * 2u; }
    const size_t kstep = (size_t)(BK * 2);
    const size_t hA = (size_t)HALF * g.lda * 2, hB = (size_t)HALF * g.ldb * 2;
    const unsigned ldsw = (unsigned)wid * 1024u;
    const int aoff = lds_byte(wr * 64 + fr, fq * 8), boff = lds_byte(wc * 32 + fr, fq * 8);
#define PG8_SA(b, h) (((b) * 2 + (h)) * HTB)
#define PG8_SB(b, h) ((4 + (b) * 2 + (h)) * HTB)
#define PG8_STAGE(bufoff, gbase, voff) do { _Pragma("unroll") for (int _i = 0; _i < 2; ++_i) \
        __builtin_amdgcn_global_load_lds((const unsigned*)((const char*)(gbase) + (voff)[_i]), (LAS unsigned*)(lds + (bufoff) + ldsw + _i * 8192), 16, 0, 0); } while (0)
#define PG8_LDA(dst, b, h) do { _Pragma("unroll") for (int m = 0; m < 4; ++m) _Pragma("unroll") for (int k = 0; k < 2; ++k) dst[m][k] = *(const LAS bf16x8*)(lds + PG8_SA(b, h) + aoff + m * 2048 + k * 1024); } while (0)
#define PG8_LDB(dst, b, h) do { _Pragma("unroll") for (int n = 0; n < 2; ++n) _Pragma("unroll") for (int k = 0; k < 2; ++k) dst[n][k] = *(const LAS bf16x8*)(lds + PG8_SB(b, h) + boff + n * 2048 + k * 1024); } while (0)
#define PG8_MMA(ai, bj, At, Bt) do { __builtin_amdgcn_s_setprio(1); _Pragma("unroll") for (int m = 0; m < 4; ++m) _Pragma("unroll") for (int n = 0; n < 2; ++n) _Pragma("unroll") for (int k = 0; k < 2; ++k) \
        acc[ai][bj][m][n] = __builtin_amdgcn_mfma_f32_16x16x32_bf16(Bt[n][k], At[m][k], acc[ai][bj][m][n], 0, 0, 0); __builtin_amdgcn_s_setprio(0); } while (0)
#define PG8_WAIT_V(n) asm volatile("s_waitcnt vmcnt(" #n ")" ::: "memory")
#define PG8_WAIT_L(n) asm volatile("s_waitcnt lgkmcnt(" #n ")" ::: "memory")
#define PG8_BAR __builtin_amdgcn_s_barrier()
#define PG8_SCHED __builtin_amdgcn_sched_barrier(0)
    Unit cur, nxt; int ui = 0;
    if (!S.next(0, cur)) return;
    f32x4 acc[2][2][4][2];
#pragma unroll
    for (int a = 0; a < 2; ++a)
#pragma unroll
        for (int b = 0; b < 2; ++b)
#pragma unroll
            for (int m = 0; m < 4; ++m)
#pragma unroll
                for (int n = 0; n < 2; ++n) acc[a][b][m][n] = (f32x4){0.f, 0.f, 0.f, 0.f};
    bf16x8 At[4][2], B0[2][2], B1[2][2];
    const char* cA = (const char*)g.A + (size_t)cur.aoff * 2; const char* cB = (const char*)g.Bt + (size_t)cur.boff * 2;
    PG8_STAGE(PG8_SB(0, 0), cB, voffB); PG8_STAGE(PG8_SB(0, 1), cB + hB, voffB); PG8_STAGE(PG8_SA(0, 0), cA, voffA); PG8_STAGE(PG8_SA(0, 1), cA + hA, voffA);
    if (wr == 1) PG8_BAR;
    PG8_WAIT_V(2); PG8_BAR;
    PG8_STAGE(PG8_SB(1, 0), cB + kstep, voffB); PG8_STAGE(PG8_SA(1, 0), cA + kstep, voffA); PG8_STAGE(PG8_SB(1, 1), cB + hB + kstep, voffB);
    PG8_WAIT_V(6); PG8_BAR;
    for (;;) {
        const bool has_next = S.next(ui + 1, nxt);
        const char* nA = has_next ? (const char*)g.A + (size_t)nxt.aoff * 2 : cA; const char* nB = has_next ? (const char*)g.Bt + (size_t)nxt.boff * 2 : cB;
        for (int t = 0; t < nt; t += 2) {
            const bool last = (t == nt - 2);
            const char* a1 = cA + (size_t)(t + 1) * kstep;
            const char* a2 = last ? nA : cA + (size_t)(t + 2) * kstep; const char* b2 = last ? nB : cB + (size_t)(t + 2) * kstep;
            const char* a3 = a2 + kstep; const char* b3 = b2 + kstep;
            PG8_LDB(B0, 0, 0); PG8_LDB(B1, 0, 1); PG8_SCHED; PG8_LDA(At, 0, 0); PG8_STAGE(PG8_SA(1, 1), a1 + hA, voffA);
            PG8_WAIT_V(8); PG8_WAIT_L(0); PG8_BAR; PG8_MMA(0, 0, At, B0); PG8_MMA(0, 1, At, B1); PG8_BAR; PG8_SCHED;
            PG8_LDA(At, 0, 1); PG8_STAGE(PG8_SB(0, 0), b2, voffB); PG8_STAGE(PG8_SB(0, 1), b2 + hB, voffB); PG8_STAGE(PG8_SA(0, 0), a2, voffA);
            PG8_WAIT_V(8); PG8_WAIT_L(0); PG8_BAR; PG8_MMA(1, 0, At, B0); PG8_MMA(1, 1, At, B1); PG8_BAR; PG8_SCHED;
            PG8_LDB(B0, 1, 0); PG8_LDB(B1, 1, 1); PG8_SCHED; PG8_LDA(At, 1, 0); PG8_STAGE(PG8_SA(0, 1), a2 + hA, voffA);
            PG8_WAIT_V(8); PG8_WAIT_L(0); PG8_BAR; PG8_MMA(0, 0, At, B0); PG8_MMA(0, 1, At, B1); PG8_BAR; PG8_SCHED;
            PG8_LDA(At, 1, 1); PG8_STAGE(PG8_SB(1, 0), b3, voffB); PG8_STAGE(PG8_SB(1, 1), b3 + hB, voffB); PG8_STAGE(PG8_SA(1, 0), a3, voffA);
            PG8_WAIT_V(8); PG8_WAIT_L(0); PG8_BAR; PG8_MMA(1, 0, At, B0); PG8_MMA(1, 1, At, B1); PG8_BAR; PG8_SCHED;
        }
        if constexpr (ALIGN_EPI) { if (wr == 0) PG8_BAR; }
        if constexpr (!Epi::AFTER_DRAIN) { E(acc, cur, wr, wc, fr, fq); }
        if (!has_next) break;
#pragma unroll
        for (int a = 0; a < 2; ++a)
#pragma unroll
            for (int b = 0; b < 2; ++b)
#pragma unroll
                for (int m = 0; m < 4; ++m)
#pragma unroll
                    for (int n = 0; n < 2; ++n) acc[a][b][m][n] = (f32x4){0.f, 0.f, 0.f, 0.f};
        cur = nxt; cA = nA; cB = nB; ++ui;
        if constexpr (ALIGN_EPI) { if (wr == 1) PG8_BAR; }
    }
    PG8_WAIT_V(0);
    if constexpr (!ALIGN_EPI) { if (wr == 0) PG8_BAR; }
    PG8_BAR;
    if constexpr (Epi::AFTER_DRAIN) { E.fused(acc, cur, wr, wc, fr, fq, lds, wid, lane); }
#undef PG8_SA
#undef PG8_SB
#undef PG8_STAGE
#undef PG8_LDA
#undef PG8_LDB
#undef PG8_MMA
#undef PG8_WAIT_V
#undef PG8_WAIT_L
#undef PG8_BAR
#undef PG8_SCHED
}
}

#define XB_TMO      128
#define XB_XCNT(j)  (256  + 64 * (j))
#define XB_XSUB(j)  (1280 + 64 * (j))
#define XB_XGEN(j)  (2304 + 64 * (j))
#define XB_TOP      3328
#define XB_TOPGEN   3392
#define XCD_BAR_WORDS 3456
#define XB_SPIN_CAP (1u << 18)
__device__ __forceinline__ unsigned xb_ld(unsigned* p)              { return __hip_atomic_load(p, __ATOMIC_RELAXED, __HIP_MEMORY_SCOPE_AGENT); }
__device__ __forceinline__ unsigned xb_add(unsigned* p, unsigned v) { return __hip_atomic_fetch_add(p, v, __ATOMIC_RELAXED, __HIP_MEMORY_SCOPE_AGENT); }
__device__ __forceinline__ unsigned xb_xcc_id() { return (unsigned)__builtin_amdgcn_s_getreg((3 << 11) | 20) & 0xFu; }
#define XB_SPIN(cond, bar) do { unsigned _sp = 0; while (cond) { __builtin_amdgcn_s_sleep(1); \
    if ((++_sp & 255u) == 0u) { if (xb_ld(&(bar)[XB_TMO])) break; if (_sp > XB_SPIN_CAP) { atomicAdd(&(bar)[XB_TMO], 1u); break; } } } } while (0)
struct XcdBarrier { unsigned* bar; unsigned x; volatile LAS unsigned* st; };
__device__ __forceinline__ XcdBarrier xcd_barrier_post(unsigned* bar, volatile LAS unsigned* st) {
    XcdBarrier b; b.bar = bar; b.x = xb_xcc_id(); b.st = st;
    if (threadIdx.x == 0) (void)xb_add(&bar[XB_XCNT(b.x)], 1u);
    return b;
}
__device__ __forceinline__ void xcd_barrier_complete(unsigned* bar, unsigned x, unsigned& nloc, unsigned& nx) {
    const unsigned G = gridDim.x * gridDim.y * gridDim.z;
    unsigned sum, cnt, mine, sp = 0u;
    for (;;) {
        sum = 0u; cnt = 0u; mine = 0u;
#pragma unroll
        for (unsigned j = 0; j < 16; ++j) { const unsigned c = xb_ld(&bar[XB_XCNT(j)]); sum += c; cnt += (c > 0u) ? 1u : 0u; mine = (j == x) ? c : mine; }
        if (sum == G) break;
        __builtin_amdgcn_s_sleep(1);
        if ((++sp & 255u) == 0u) { if (xb_ld(&bar[XB_TMO])) break; if (sp > XB_SPIN_CAP) { atomicAdd(&bar[XB_TMO], 1u); break; } }
    }
    nloc = mine > 0u ? mine : 1u; nx = cnt > 0u ? cnt : 1u;
}
__device__ __forceinline__ void xcd_barrier(const XcdBarrier& b) {
    asm volatile("s_waitcnt vmcnt(0)" ::: "memory");
    __syncthreads();
    if (threadIdx.x == 0) {
        unsigned* bar = b.bar;
        __builtin_amdgcn_s_waitcnt(0);
        unsigned nloc = b.st[0], nx = b.st[1];
        if (nloc == 0u) { xcd_barrier_complete(bar, b.x, nloc, nx); b.st[0] = nloc; b.st[1] = nx; }
        const unsigned old = xb_add(&bar[XB_XSUB(b.x)], 1u);
        const unsigned gen = old / nloc;
        if (old + 1u == (gen + 1u) * nloc) {
            __builtin_amdgcn_fence(__ATOMIC_RELEASE, "agent");
            asm volatile("s_waitcnt vmcnt(0)" ::: "memory");
            const unsigned og = xb_add(&bar[XB_TOP], 1u);
            const unsigned tg = og / nx;
            if (og + 1u == (tg + 1u) * nx) xb_add(&bar[XB_TOPGEN], 1u);
            else XB_SPIN(xb_ld(&bar[XB_TOPGEN]) == tg, bar);
            __builtin_amdgcn_fence(__ATOMIC_ACQUIRE, "agent");
            xb_add(&bar[XB_XGEN(b.x)], 1u);
            asm volatile("s_waitcnt vmcnt(0)" ::: "memory");
        } else {
            XB_SPIN(xb_ld(&bar[XB_XGEN(b.x)]) == gen, bar);
            __builtin_amdgcn_fence(__ATOMIC_ACQUIRE, "agent");
            asm volatile("s_waitcnt vmcnt(0)" ::: "memory");
        }
    }
    __syncthreads();
}

enum { I_X = 0, I_MEM, I_FFN1_NORM, I_FFN1_WIN, I_FFN1_WOUT, I_MIX_NORM, I_WMIXIN, I_CONV_W, I_CONV_B, I_CONV_LN_G, I_CONV_LN_B, I_SGU_LN_G, I_SGU_LN_B, I_SGU_W, I_SGU_B,
       I_OUT_NORM_CONV, I_OUT_NORM_SGU, I_WMIXOUT, I_XATTN_NORM, I_MEM_NORM, I_WQ, I_WKV, I_WO, I_FFN2_NORM, I_FFN2_WIN, I_FFN2_WOUT, I_FINAL_NORM, N_IN };
struct Args { const float* in[N_IN]; float* out; unsigned char* ws; int ph_lo, ph_hi, coop, pad; };
typedef const __attribute__((address_space(4))) unsigned char* kptr_t;
__device__ __forceinline__ int opaque0() { int z; asm volatile("s_mov_b32 %0, 0" : "=s"(z)); return z; }
#define KIN(i) (*(const float* const __attribute__((address_space(4)))*)(kp + kz + 8 * (i)))

__host__ __device__ __forceinline__ int mix_tile_swap(int t) { return ((t & 12) == 4 || (t & 12) == 8) ? (t ^ 12) : t; }
__device__ __forceinline__ int rowmap(int mode, int n0) {
    if (mode == 1) { const int bj = n0 / FF, j = n0 - bj * FF; return 256 * (j >> 7) + 128 * bj + (j & 127); }
    if (mode == 2) { int r = n0; if (n0 < 2048) { const int bj = n0 >> 10, j = n0 & 1023; r = 256 * (j >> 7) + 128 * bj + (j & 127); } return 256 * mix_tile_swap(r >> 8) + (r & 255); }
    return n0;
}
struct ItemD { const float* W; const float* g; bf16_t* WT; int K, N, mode, it; };
__device__ __forceinline__ void p0_load(const ItemD& d, int lane, f32x4 (&v)[16], float (&gv)[16]) {
    const int nblk = d.N / 64, kb = d.it / nblk, nb = d.it - kb * nblk, k0 = 64 * kb, n0 = 64 * nb, kr = lane >> 4, c4 = lane & 15;
#pragma unroll
    for (int i = 0; i < 16; ++i) v[i] = __builtin_nontemporal_load((const f32x4*)(d.W + (size_t)(k0 + 4 * i + kr) * d.N + n0 + 4 * c4));
#pragma unroll
    for (int i = 0; i < 16; ++i) gv[i] = d.g ? d.g[k0 + 4 * i + kr] : 1.0f;
}
__device__ __forceinline__ void p0_finish(const ItemD& d, int lane, LAS float* scr, const f32x4 (&v)[16], const float (&gv)[16]) {
    const int nblk = d.N / 64, kb = d.it / nblk, nb = d.it - kb * nblk, k0 = 64 * kb, n0 = 64 * nb, kr = lane >> 4, c4 = lane & 15;
    const int drow = rowmap(d.mode, n0);
#pragma unroll
    for (int i = 0; i < 16; ++i) { LAS float* p = scr + (4 * i + kr) * 65 + 4 * c4; const f32x4 x = v[i] * gv[i]; p[0] = x[0]; p[1] = x[1]; p[2] = x[2]; p[3] = x[3]; }
    asm volatile("s_waitcnt lgkmcnt(0)" ::: "memory");
    const int c = lane & 7, nl = lane >> 3;
#pragma unroll
    for (int j = 0; j < 8; ++j) { const int n = nl + 8 * j; const LAS float* s = scr + (8 * c) * 65 + n;
        u32x4 o; o.x = cvt_pk_bf16(s[0 * 65], s[1 * 65]); o.y = cvt_pk_bf16(s[2 * 65], s[3 * 65]); o.z = cvt_pk_bf16(s[4 * 65], s[5 * 65]); o.w = cvt_pk_bf16(s[6 * 65], s[7 * 65]);
        *(u32x4*)(d.WT + (size_t)(drow + n) * d.K + k0 + 8 * c) = o; }
    asm volatile("s_waitcnt lgkmcnt(0)" ::: "memory");
}

template <int J> struct ConvJ { static __device__ __forceinline__ void run(f32x2 (&ov)[16], const f32x2 (&wk)[31], const bf16_t* ABcol, int t0, int tb) {
    const int t = t0 - 30 + J; unsigned v = 0u; if (t >= tb) v = *(const unsigned*)(ABcol + (size_t)t * CCH);
    const f32x2 a = (f32x2){bf_lo(v), bf_hi(v)};
#pragma unroll
    for (int r = 0; r < 16; ++r) { const int k = J - r; if (k >= 0 && k < 31) ov[r] += wk[k] * a; }
    if constexpr (J + 1 < 46) ConvJ<J + 1>::run(ov, wk, ABcol, t0, tb);
} };

__global__ void __launch_bounds__(NTHR, 2) fwd_megakernel(Args args) {
    extern __shared__ __attribute__((aligned(16))) unsigned char lds_raw[];
    LAS unsigned char* lds = (LAS unsigned char*)lds_raw;
    cg::grid_group grid = cg::this_grid();
    const int tid = threadIdx.x, lane = tid & 63, wave = __builtin_amdgcn_readfirstlane(tid >> 6);
    const int G = gridDim.x, bid = blockIdx.x;
    const kptr_t kp = (kptr_t)__builtin_amdgcn_kernarg_segment_ptr();
    const int lo = args.ph_lo, hi = args.ph_hi; const bool coop = args.coop != 0;
    unsigned char* ws = args.ws;
    bf16_t* W1IN = (bf16_t*)(ws + WS_W1IN); bf16_t* W1OUT = (bf16_t*)(ws + WS_W1OUT); bf16_t* W2IN = (bf16_t*)(ws + WS_W2IN); bf16_t* W2OUT = (bf16_t*)(ws + WS_W2OUT);
    bf16_t* WMIXIN = (bf16_t*)(ws + WS_WMIXIN); bf16_t* WMIXOUT = (bf16_t*)(ws + WS_WMIXOUT); bf16_t* WKV = (bf16_t*)(ws + WS_WKV); bf16_t* WO = (bf16_t*)(ws + WS_WO);
    bf16_t* WSGU = (bf16_t*)(ws + WS_WSGU); bf16_t* MEMN = (bf16_t*)(ws + WS_MEMN); bf16_t* KV = (bf16_t*)(ws + WS_KMAT);     bf16_t* VWOT = (bf16_t*)(ws + WS_XR); bf16_t* QKT = (bf16_t*)(ws + WS_XR + 8 * MiB);     bf16_t* WQN = (bf16_t*)(ws + WS_WQ);
    float* PART = (float*)(ws + WS_PART); float* VSTAT = (float*)(ws + WS_VSTAT); bf16_t* XB = (bf16_t*)(ws + WS_XB); bf16_t* ACT = (bf16_t*)(ws + WS_ACT);
    bf16_t* AB = (bf16_t*)(ws + WS_AB); bf16_t* UB = (bf16_t*)(ws + WS_UB); bf16_t* VB = (bf16_t*)(ws + WS_VB); bf16_t* Y = (bf16_t*)(ws + WS_Y);
    bf16_t* P = (bf16_t*)(ws + WS_P);
#define IN(k) (lo <= (k) && (k) < hi)
    volatile LAS unsigned* bst = (volatile LAS unsigned*)(lds + LDS_BYTES - 64);
    if (tid < 16) bst[tid] = 0u;
    __syncthreads();
    XcdBarrier xbar; xbar.bar = (unsigned*)(ws + WS_CTL); xbar.x = 0; xbar.st = bst;
    if (coop) xbar = xcd_barrier_post((unsigned*)(ws + WS_CTL), bst);
    if (args.coop == 2) grid.sync();
#define SEAM(k) do { if (coop && IN(k) && IN((k) + 1)) xcd_barrier(xbar); } while (0)

    if (IN(0)) { const int kz = opaque0();
        LAS float* scr = (LAS float*)(lds + wave * 16640);
        const int gw = bid * NWAVES + wave, NGW = G * NWAVES;
        constexpr int I_FIN = (D / 64) * (2 * FF / 64), I_FOUT = (FF / 64) * (D / 64), I_MIN = (D / 64) * (4096 / 64), I_SQ = (D / 64) * (D / 64), I_KV = (D / 64) * (4096 / 64);
        constexpr int NITEMS = 2 * I_FIN + 2 * I_FOUT + I_MIN + 2 * I_SQ + I_KV;
        const float *w_f1i = KIN(I_FFN1_WIN), *w_f2i = KIN(I_FFN2_WIN), *w_f1o = KIN(I_FFN1_WOUT), *w_f2o = KIN(I_FFN2_WOUT), *w_mi = KIN(I_WMIXIN), *w_mo = KIN(I_WMIXOUT), *w_q = KIN(I_WQ), *w_o = KIN(I_WO), *w_kv = KIN(I_WKV);
        const float *g_f1 = KIN(I_FFN1_NORM), *g_f2 = KIN(I_FFN2_NORM), *g_mi = KIN(I_MIX_NORM), *g_xa = KIN(I_XATTN_NORM);
#define P0_DECODE(r_, d_) do { int r = (r_); \
        if (r < I_FIN) { d_ = ItemD{w_f1i, g_f1, W1IN, D, 2 * FF, 1, r}; break; } r -= I_FIN; \
        if (r < I_KV) { d_ = ItemD{w_kv, nullptr, WKV, D, 4096, 0, r}; break; } r -= I_KV; \
        if (r < I_MIN) { d_ = ItemD{w_mi, g_mi, WMIXIN, D, 4096, 2, r}; break; } r -= I_MIN; \
        if (r < I_SQ) { d_ = ItemD{w_mo, nullptr, WMIXOUT, D, D, 0, r}; break; } r -= I_SQ; \
        if (r < I_SQ) { d_ = ItemD{w_o, nullptr, WO, D, D, 0, r}; break; } r -= I_SQ; \
        if (r < I_FOUT) { d_ = ItemD{w_f1o, nullptr, W1OUT, FF, D, 0, r}; break; } r -= I_FOUT; \
        if (r < I_FIN) { d_ = ItemD{w_f2i, g_f2, W2IN, D, 2 * FF, 1, r}; break; } r -= I_FIN; \
        d_ = ItemD{w_f2o, nullptr, W2OUT, FF, D, 0, r}; } while (0)
        {
            const int nit0 = (G == 256) ? NITEMS - I_FIN - 2 * I_FOUT : NITEMS;
            int it = gw; ItemD dc{}; f32x4 v[16]; float gv[16];
            if (it < nit0) { P0_DECODE(it, dc); p0_load(dc, lane, v, gv); }
            while (it < nit0) {
                const int nx = it + NGW; const bool hn = nx < nit0; ItemD dn{}; f32x4 vn[16]; float gn[16];
                if (hn) { P0_DECODE(nx, dn); p0_load(dn, lane, vn, gn); }
                p0_finish(dc, lane, scr, v, gv);
                if (hn) { dc = dn;
#pragma unroll
                    for (int i = 0; i < 16; ++i) { v[i] = vn[i]; gv[i] = gn[i]; } }
                it = nx;
            }
        }
#undef P0_DECODE
        for (int i0 = bid * NTHR + tid; i0 < D * D / 8; i0 += 4 * G * NTHR) { f32x4 qa[4], qb[4];
#pragma unroll
            for (int r = 0; r < 4; ++r) { const int idx = i0 + r * G * NTHR; if (idx < D * D / 8) { qa[r] = __builtin_nontemporal_load((const f32x4*)(w_q + (size_t)idx * 8)); qb[r] = __builtin_nontemporal_load((const f32x4*)(w_q + (size_t)idx * 8 + 4)); } }
#pragma unroll
            for (int r = 0; r < 4; ++r) { const int idx = i0 + r * G * NTHR; if (idx < D * D / 8) { const float gk = g_xa[idx >> 8]; const f32x4 a = qa[r], b = qb[r];
                u32x4 w; w.x = cvt_pk_bf16(a[0] * gk, a[1] * gk); w.y = cvt_pk_bf16(a[2] * gk, a[3] * gk); w.z = cvt_pk_bf16(b[0] * gk, b[1] * gk); w.w = cvt_pk_bf16(b[2] * gk, b[3] * gk);
                *(u32x4*)(WQN + (size_t)idx * 8) = w; } } }
        for (int m0 = gw; m0 < T; m0 += 4 * NGW) { f32x4 xv[4][8]; const float* xin = KIN(I_X);
#pragma unroll
            for (int r = 0; r < 4; ++r) { const int m = m0 + r * NGW; if (m < T) { const f32x4* xr = (const f32x4*)(xin + (size_t)m * D) + lane;
#pragma unroll
                for (int j = 0; j < 8; ++j) xv[r][j] = __builtin_nontemporal_load(xr + 64 * j); } }
#pragma unroll
            for (int r = 0; r < 4; ++r) { const int m = m0 + r * NGW; if (m < T) { u32x2* o = (u32x2*)(XB + (size_t)m * D) + lane; float s = 0.f;
#pragma unroll
                for (int j = 0; j < 8; ++j) { const f32x4 v = xv[r][j]; s += (v[0] * v[0] + v[1] * v[1]) + (v[2] * v[2] + v[3] * v[3]); u32x2 w; w.x = cvt_pk_bf16(v[0], v[1]); w.y = cvt_pk_bf16(v[2], v[3]); o[64 * j] = w; }
                s += __shfl_xor(s, 32); if (lane < 32) PART[(size_t)m * NPART + lane] = s; } }
        }
        for (int m = gw; m < 2 * NMEM; m += NGW) {
            const f32x4* xr = (const f32x4*)(KIN(I_MEM) + (size_t)m * D) + lane; const f32x4* gr = (const f32x4*)KIN(I_MEM_NORM) + lane; u32x2* o = (u32x2*)(MEMN + (size_t)m * D) + lane;
            f32x4 v[8]; float s = 0.f;
#pragma unroll
            for (int j = 0; j < 8; ++j) { v[j] = xr[64 * j]; s += (v[j][0] * v[j][0] + v[j][1] * v[j][1]) + (v[j][2] * v[j][2] + v[j][3] * v[j][3]); }
            const float rstd = rsqrtf(wave_sum(s) * (1.0f / D) + RMS_EPS);
#pragma unroll
            for (int j = 0; j < 8; ++j) { const f32x4 gg = gr[64 * j]; const f32x4 y = v[j] * rstd * gg; u32x2 w; w.x = cvt_pk_bf16(y[0], y[1]); w.y = cvt_pk_bf16(y[2], y[3]); o[64 * j] = w; }
        }
        for (int idx = bid * NTHR + tid; idx < 8 * 128 * 128; idx += G * NTHR) { const int i = (idx >> 7) & 127, j = idx & 127; const float w = ((j >> 6) <= (i >> 6)) ? KIN(I_SGU_W)[idx] : 0.f;
            WSGU[idx] = (bf16_t)(cvt_pk_bf16(w, 0.f) & 0xffffu); }
    }
    SEAM(0);

    if (IN(1)) { const int kz = opaque0();
        unsigned* kvcnt = (unsigned*)(ws + WS_CTL) + 6400;
        { pg8::Gemm g{MEMN, WKV, D, D, D}; pg8::PlainOrder S; S.init(2 * NMEM, 2 * D, G, (bid + G - G / 2) % G, D, D); pg8::EpiBf16Pub E{KV, 2 * D, kvcnt};
          pg8::gemm_phase<pg8::EpiBf16Pub, pg8::PlainOrder, true>(lds, g, S, E); }
        { pg8::Gemm g{XB, W1IN, D, D, D}; pg8::PlainOrder S; S.init(T, 2 * FF, G, bid, D, D); pg8::EpiSwiGLU E{ACT, PART};
          pg8::gemm_phase<pg8::EpiSwiGLU, pg8::PlainOrder, true>(lds, g, S, E); }
        for (int v = (bid + G - (160 % G)) % G; v < 64; v += G) { const int b = v >> 5, h = (v >> 3) & 3, nt = v & 7;
            if (tid < 64) { unsigned sp = 0; while ((unsigned)__builtin_amdgcn_readfirstlane(__hip_atomic_load(kvcnt, __ATOMIC_RELAXED, __HIP_MEMORY_SCOPE_AGENT)) < 256u) { __builtin_amdgcn_s_sleep(8); if (++sp > (1u << 20)) break; } }
            __syncthreads(); __builtin_amdgcn_fence(__ATOMIC_ACQUIRE, "agent"); asm volatile("s_waitcnt vmcnt(0)" ::: "memory");
            pg8::OneUnit S; S.u.pm = h; S.u.pn = nt; S.u.aoff = (unsigned)(b * 256) * (2 * D) + h * 512; S.u.boff = (unsigned)(nt * 256) * D + h * 512;
            pg8::Gemm g{KV, WQN, 2 * D, D, 512 + kz}; pg8::EpiBf16S E{QKT + (size_t)b * 1024 * D, D, nullptr, 1.0f};
            pg8::gemm_phase<pg8::EpiBf16S, pg8::OneUnit, false>(lds, g, S, E); }
        if (G == 256 && bid >= 160) {
            LAS float* scr = (LAS float*)(lds + wave * 16640); const int gw = (bid - 160) * NWAVES + wave, NGW = 96 * NWAVES;
            constexpr int NIT = (FF / 64) * (D / 64); const float* w_f1o = KIN(I_FFN1_WOUT);
#define P1_DECODE(r_, d_) do { d_ = ItemD{w_f1o, nullptr, W1OUT, FF, D, 0, (r_)}; } while (0)
            int it = gw; ItemD dc{}; f32x4 v[16]; float gv[16];
            if (it < NIT) { P1_DECODE(it, dc); p0_load(dc, lane, v, gv); }
            while (it < NIT) {
                const int nx = it + NGW; const bool hn = nx < NIT; ItemD dn{}; f32x4 vn[16]; float gn[16];
                if (hn) { P1_DECODE(nx, dn); p0_load(dn, lane, vn, gn); }
                p0_finish(dc, lane, scr, v, gv);
                if (hn) { dc = dn;
#pragma unroll
                    for (int i = 0; i < 16; ++i) { v[i] = vn[i]; gv[i] = gn[i]; } }
                it = nx;
            }
#undef P1_DECODE
        }
    }
    SEAM(1);

    if (IN(2)) { const int kz = opaque0();
        pg8::Gemm g{ACT, W1OUT, FF, FF, FF}; pg8::PlainOrder S; S.init(T, D, G, bid, FF, FF); pg8::EpiResid E{XB, PART, 0.5f};
        pg8::gemm_phase<pg8::EpiResid, pg8::PlainOrder, true>(lds, g, S, E);
    }
    SEAM(2);

    if (IN(3)) { const int kz = opaque0();
        pg8::Gemm g{XB, WMIXIN, D, D, D}; pg8::MixOrder S; S.init(T, 4096, G, bid, D, D); pg8::EpiMixIn E{AB, UB, VB, VSTAT, PART};
        pg8::gemm_phase<pg8::EpiMixIn, pg8::MixOrder, true>(lds, g, S, E);
    }
    SEAM(3);

    if (IN(4)) { const int kz = opaque0();
        for (int cu = bid; cu < T / 32; cu += G) {
            const int t0 = cu * 32, tb = (t0 / SEQ) * SEQ;
            f32x2 wk[31];
#pragma unroll
            for (int k = 0; k < 31; ++k) wk[k] = *(const f32x2*)(KIN(I_CONV_W) + k * CCH + 2 * tid);
            const f32x2 cb = *(const f32x2*)(KIN(I_CONV_B) + 2 * tid);
            LAS float* Os = (LAS float*)lds;
#pragma unroll 1
            for (int hf = 0; hf < 2; ++hf) {
                f32x2 ov[16];
#pragma unroll
                for (int r = 0; r < 16; ++r) ov[r] = cb;
                ConvJ<0>::run(ov, wk, AB + 2 * tid, t0 + 16 * hf, tb);
#pragma unroll
                for (int r = 0; r < 16; ++r) *(LAS f32x2*)(Os + (16 * hf + r) * CCH + 2 * tid) = ov[r];
            }
            __syncthreads();
#pragma unroll
            for (int rr = 0; rr < 4; ++rr) { const int r = wave * 4 + rr; f32x4 x[4]; float s = 0.f;
#pragma unroll
                for (int j = 0; j < 4; ++j) { x[j] = *(const LAS f32x4*)(Os + r * CCH + j * 256 + 4 * lane); s += (x[j][0] + x[j][1]) + (x[j][2] + x[j][3]); }
                const float mean = wave_sum(s) * (1.0f / CCH); float q = 0.f;
#pragma unroll
                for (int j = 0; j < 4; ++j) { x[j] = x[j] - mean; q += (x[j][0] * x[j][0] + x[j][1] * x[j][1]) + (x[j][2] * x[j][2] + x[j][3] * x[j][3]); }
                const float rstd = rsqrtf(wave_sum(q) * (1.0f / CCH) + LN_EPS); float z2 = 0.f;
#pragma unroll
                for (int j = 0; j < 4; ++j) { const f32x4 gg = *(const f32x4*)(KIN(I_CONV_LN_G) + j * 256 + 4 * lane), bb = *(const f32x4*)(KIN(I_CONV_LN_B) + j * 256 + 4 * lane);
                    f32x4 y = x[j] * rstd * gg + bb;
#pragma unroll
                    for (int e = 0; e < 4; ++e) { y[e] = y[e] * sigmoidf_(y[e]); z2 += y[e] * y[e]; }
                    x[j] = y; }
                const float r2 = rsqrtf(wave_sum(z2) * (1.0f / CCH) + RMS_EPS);
#pragma unroll
                for (int j = 0; j < 4; ++j) { const f32x4 gg = *(const f32x4*)(KIN(I_OUT_NORM_CONV) + j * 256 + 4 * lane); const f32x4 y = x[j] * r2 * gg;
                    u32x2 w; w.x = cvt_pk_bf16(y[0], y[1]); w.y = cvt_pk_bf16(y[2], y[3]); st8_wt(Y + (size_t)(t0 + r) * D + j * 256 + 4 * lane, w); }
            }
            __syncthreads();
        }
        for (int su = bid; su < T / 32; su += G) {
            const int tc0 = (su >> 2) * 128, qi = su & 3, i0 = 32 * qi, J = qi < 2 ? 64 : 128;
            constexpr int LDB = 136;
            LAS bf16_t* Bt = (LAS bf16_t*)lds;
            LAS f32x2* st = (LAS f32x2*)(lds + 2 * 128 * LDB * 2);
            LAS float* red = (LAS float*)(lds + 2 * 128 * LDB * 2 + 1024);
            if (tid < J) { const f32x4* p = (const f32x4*)(VSTAT + (size_t)(tc0 + tid) * 32); float s1 = 0.f, s2 = 0.f;
#pragma unroll
                for (int j = 0; j < 8; ++j) { const f32x4 v = p[j]; s1 += v[0] + v[2]; s2 += v[1] + v[3]; }
                const float mean = s1 * (1.0f / CCH), var = fmaxf(s2 * (1.0f / CCH) - mean * mean, 0.f); st[tid] = (f32x2){mean, rsqrtf(var + LN_EPS)}; }
            const int mb = wave & 1, nq = wave >> 1, fr = lane & 15, fq = lane >> 4;
            const int trow = tc0 + i0 + 16 * mb + fr;
            const float* lng = KIN(I_SGU_LN_G); const float* lnb = KIN(I_SGU_LN_B); const float* sgb = KIN(I_SGU_B);
            const int c8 = tid & 15, jb = tid >> 4, nk = J / 32;
            u32x4 pv[4]; f32x4 pg0, pg1, pb0, pb1; bf16x8 pw[4]; u32x2 pu0, pu1; float pbs;
#define SGU_PREFETCH(h_) do { \
    _Pragma("unroll") for (int k = 0; k < 4; ++k) if (k < nk) pv[k] = *(const u32x4*)(VB + (size_t)(tc0 + jb + 32 * k) * CCH + (h_) * 128 + c8 * 8); \
    pg0 = *(const f32x4*)(lng + (h_) * 128 + c8 * 8); pg1 = *(const f32x4*)(lng + (h_) * 128 + c8 * 8 + 4); pb0 = *(const f32x4*)(lnb + (h_) * 128 + c8 * 8); pb1 = *(const f32x4*)(lnb + (h_) * 128 + c8 * 8 + 4); \
    _Pragma("unroll") for (int ks = 0; ks < 4; ++ks) if (ks < nk) pw[ks] = *(const bf16x8*)(WSGU + (size_t)(h_) * 16384 + (i0 + 16 * mb + fr) * 128 + ks * 32 + fq * 8); \
    pbs = sgb[(h_) * 128 + i0 + 16 * mb + fr]; \
    pu0 = *(const u32x2*)(UB + (size_t)trow * CCH + (h_) * 128 + 32 * nq + 4 * fq); pu1 = *(const u32x2*)(UB + (size_t)trow * CCH + (h_) * 128 + 32 * nq + 4 * fq + 16); } while (0)
            f32x4 yv[8][2]; float ss = 0.f;
            SGU_PREFETCH(0);
            __syncthreads();
#pragma unroll
            for (int h = 0; h < 8; ++h) {
                LAS bf16_t* Bc = Bt + (h & 1) * (128 * LDB);
#pragma unroll
                for (int k = 0; k < 4; ++k) if (k < nk) { const int j = jb + 32 * k; const u32x4 v = pv[k]; const f32x2 ms = st[j];
                    const f32x4 x0 = (f32x4){bf_lo(v.x), bf_hi(v.x), bf_lo(v.y), bf_hi(v.y)}, x1 = (f32x4){bf_lo(v.z), bf_hi(v.z), bf_lo(v.w), bf_hi(v.w)};
                    const f32x4 y0 = (x0 - ms.x) * ms.y * pg0 + pb0, y1 = (x1 - ms.x) * ms.y * pg1 + pb1;
                    LAS bf16_t* d = Bc + (c8 * 8) * LDB + (j ^ (8 * c8));
                    const unsigned p0 = cvt_pk_bf16(y0[0], y0[1]), p1 = cvt_pk_bf16(y0[2], y0[3]), p2 = cvt_pk_bf16(y1[0], y1[1]), p3 = cvt_pk_bf16(y1[2], y1[3]);
                    d[0 * LDB] = (bf16_t)(p0 & 0xffffu); d[1 * LDB] = (bf16_t)(p0 >> 16); d[2 * LDB] = (bf16_t)(p1 & 0xffffu); d[3 * LDB] = (bf16_t)(p1 >> 16);
                    d[4 * LDB] = (bf16_t)(p2 & 0xffffu); d[5 * LDB] = (bf16_t)(p2 >> 16); d[6 * LDB] = (bf16_t)(p3 & 0xffffu); d[7 * LDB] = (bf16_t)(p3 >> 16); }
                bf16x8 cw[4];
#pragma unroll
                for (int ks = 0; ks < 4; ++ks) cw[ks] = pw[ks];
                const u32x2 u0 = pu0, u1 = pu1; const float bs = pbs;
                __syncthreads();
                if (h + 1 < 8) SGU_PREFETCH(h + 1);
                f32x4 a0 = (f32x4){0.f, 0.f, 0.f, 0.f}, a1 = a0;
#pragma unroll
                for (int ks = 0; ks < 4; ++ks) if (ks < nk) {
                    const int r0 = 16 * (2 * nq) + fr, r1 = r0 + 16, q = ks * 4 + fq;
                    const bf16x8 x0 = *(const LAS bf16x8*)(Bc + r0 * LDB + ((q ^ ((r0 >> 3) & 15)) * 8)), x1 = *(const LAS bf16x8*)(Bc + r1 * LDB + ((q ^ ((r1 >> 3) & 15)) * 8));
                    a0 = __builtin_amdgcn_mfma_f32_16x16x32_bf16(x0, cw[ks], a0, 0, 0, 0); a1 = __builtin_amdgcn_mfma_f32_16x16x32_bf16(x1, cw[ks], a1, 0, 0, 0);
                }
                const f32x4 uu0 = (f32x4){bf_lo(u0.x), bf_hi(u0.x), bf_lo(u0.y), bf_hi(u0.y)}, uu1 = (f32x4){bf_lo(u1.x), bf_hi(u1.x), bf_lo(u1.y), bf_hi(u1.y)};
                const f32x4 y0 = uu0 * (a0 + bs), y1 = uu1 * (a1 + bs);
                ss += ((y0[0] * y0[0] + y0[1] * y0[1]) + (y0[2] * y0[2] + y0[3] * y0[3])) + ((y1[0] * y1[0] + y1[1] * y1[1]) + (y1[2] * y1[2] + y1[3] * y1[3]));
                yv[h][0] = y0; yv[h][1] = y1;
            }
#undef SGU_PREFETCH
            ss += __shfl_xor(ss, 16); ss += __shfl_xor(ss, 32);
            if (fq == 0) red[(mb * 4 + nq) * 16 + fr] = ss;
            __syncthreads();
            const float tot = (red[(mb * 4 + 0) * 16 + fr] + red[(mb * 4 + 1) * 16 + fr]) + (red[(mb * 4 + 2) * 16 + fr] + red[(mb * 4 + 3) * 16 + fr]);
            const float r2 = rsqrtf(tot * (1.0f / CCH) + RMS_EPS);
#pragma unroll
            for (int h = 0; h < 8; ++h)
#pragma unroll
                for (int nb = 0; nb < 2; ++nb) { const int ch = h * 128 + 32 * nq + 16 * nb + 4 * fq; const f32x4 gg = *(const f32x4*)(KIN(I_OUT_NORM_SGU) + ch); const f32x4 y = yv[h][nb] * r2 * gg;
                    u32x2 w; w.x = cvt_pk_bf16(y[0], y[1]); w.y = cvt_pk_bf16(y[2], y[3]); st8_wt(Y + (size_t)trow * D + CCH + ch, w); }
            __syncthreads();
        }
    }
    SEAM(4);

    if (IN(5)) { const int kz = opaque0();
        pg8::Gemm g{Y, WMIXOUT, D, D, D}; pg8::PlainOrder S; S.init(T, D, G, bid, D, D); pg8::EpiResid E{XB, PART, 1.0f};
        pg8::gemm_phase<pg8::EpiResid, pg8::PlainOrder, true>(lds, g, S, E);
    }
    SEAM(5);

    if (IN(6)) { const int kz = opaque0();
        for (int L = bid; L < 128; L += G) { const int h = L & 3, pm = L >> 2;
            pg8::OneUnit S; S.u.pm = pm; S.u.pn = h; S.u.aoff = (unsigned)pm * 256 * D; S.u.boff = (unsigned)((pm >> 4) * 1024 + h * 256) * D;
            pg8::Gemm g{XB, QKT, D, D, D + kz}; pg8::EpiSoftmax E{P, PART, 0.044194173824159216f * 1.4426950408889634f};
            pg8::gemm_phase<pg8::EpiSoftmax, pg8::OneUnit, false>(lds, g, S, E); }
        for (int v = (bid + G - (128 % G)) % G; v < 64; v += G) { const int b = v >> 5, h = (v >> 3) & 3, nt = v & 7;
            pg8::OneUnit S; S.u.pm = nt; S.u.pn = h; S.u.aoff = (unsigned)nt * 256 * D + h * 512; S.u.boff = (unsigned)(b * 256) * (2 * D) + D + h * 512;
            pg8::Gemm g{WO, KV, D, 2 * D, 512 + kz}; pg8::EpiBf16S E{VWOT + (size_t)b * D * 1024, 1024, nullptr, 1.0f};
            pg8::gemm_phase<pg8::EpiBf16S, pg8::OneUnit, false>(lds, g, S, E); }
        if (G == 256 && bid >= 128) {
            LAS float* scr = (LAS float*)(lds + wave * 16640); const int gw = (bid - 128) * NWAVES + wave, NGW = 128 * NWAVES;
            constexpr int I_FIN = (D / 64) * (2 * FF / 64), NIT = I_FIN;
            const float *w_f2i = KIN(I_FFN2_WIN), *g_f2 = KIN(I_FFN2_NORM);
#define P6_DECODE(r_, d_) do { d_ = ItemD{w_f2i, g_f2, W2IN, D, 2 * FF, 1, (r_)}; } while (0)
            int it = gw; ItemD dc{}; f32x4 v[16]; float gv[16];
            if (it < NIT) { P6_DECODE(it, dc); p0_load(dc, lane, v, gv); }
            while (it < NIT) {
                const int nx = it + NGW; const bool hn = nx < NIT; ItemD dn{}; f32x4 vn[16]; float gn[16];
                if (hn) { P6_DECODE(nx, dn); p0_load(dn, lane, vn, gn); }
                p0_finish(dc, lane, scr, v, gv);
                if (hn) { dc = dn;
#pragma unroll
                    for (int i = 0; i < 16; ++i) { v[i] = vn[i]; gv[i] = gn[i]; } }
                it = nx;
            }
#undef P6_DECODE
        }
    }
    SEAM(6);

    if (IN(8) && !IN(7)) { }

    if (IN(9)) { const int kz = opaque0();
        pg8::Gemm g{P, VWOT, 1024, 1024, 1024 + kz}; pg8::BatchBOrder S; S.init(T, D, G, bid, 1024, 1024, (unsigned)D * 1024); pg8::EpiResid E{XB, PART, 1.0f};
        pg8::gemm_phase<pg8::EpiResid, pg8::BatchBOrder, true>(lds, g, S, E);
    }
    SEAM(9);

    if (IN(10)) { const int kz = opaque0();
        pg8::Gemm g{XB, W2IN, D, D, D}; pg8::PlainOrder S; S.init(T, 2 * FF, G, bid, D, D); pg8::EpiSwiGLU E{ACT, PART};
        pg8::gemm_phase<pg8::EpiSwiGLU, pg8::PlainOrder, true>(lds, g, S, E);
        if (G == 256 && bid >= 128) {
            LAS float* scr = (LAS float*)(lds + wave * 16640); const int gw = (bid - 128) * NWAVES + wave, NGW = 128 * NWAVES;
            constexpr int NIT = (FF / 64) * (D / 64); const float* w_f2o = KIN(I_FFN2_WOUT);
#define P10_DECODE(r_, d_) do { d_ = ItemD{w_f2o, nullptr, W2OUT, FF, D, 0, (r_)}; } while (0)
            int it = gw; ItemD dc{}; f32x4 v[16]; float gv[16];
            if (it < NIT) { P10_DECODE(it, dc); p0_load(dc, lane, v, gv); }
            while (it < NIT) {
                const int nx = it + NGW; const bool hn = nx < NIT; ItemD dn{}; f32x4 vn[16]; float gn[16];
                if (hn) { P10_DECODE(nx, dn); p0_load(dn, lane, vn, gn); }
                p0_finish(dc, lane, scr, v, gv);
                if (hn) { dc = dn;
#pragma unroll
                    for (int i = 0; i < 16; ++i) { v[i] = vn[i]; gv[i] = gn[i]; } }
                it = nx;
            }
#undef P10_DECODE
        }
    }
    SEAM(10);

    if (IN(11)) { const int kz = opaque0();
        pg8::Gemm g{ACT, W2OUT, FF, FF, FF}; pg8::PlainOrder S; S.init(T, D, G, bid, FF, FF);
        if (G == 256 && coop) {
            pg8::EpiFinal E{XB, PART, (unsigned*)(ws + WS_CTL) + 4096, KIN(I_FINAL_NORM), args.out, 0.5f, (LAS float*)(lds + RING_BYTES + 2048)};
            pg8::gemm_phase<pg8::EpiFinal, pg8::PlainOrder, true>(lds, g, S, E);
        } else {
            pg8::EpiResid E{XB, PART, 0.5f};
            pg8::gemm_phase<pg8::EpiResid, pg8::PlainOrder, true>(lds, g, S, E);
        }
    }
    if (!(G == 256 && coop)) SEAM(11);

    if (IN(12) && !(G == 256 && coop)) { const int kz = opaque0();
        const int gw = bid * NWAVES + wave, NGW = G * NWAVES;
        for (int m = gw; m < T; m += NGW) {
            const u32x4* xr = (const u32x4*)(XB + (size_t)m * D) + lane; const float* gr = KIN(I_FINAL_NORM); float* o = args.out + (size_t)m * D;
            f32x4 v[8]; float s = 0.f;
#pragma unroll
            for (int j = 0; j < 4; ++j) { const u32x4 r = xr[64 * j]; v[2 * j] = (f32x4){bf_lo(r.x), bf_hi(r.x), bf_lo(r.y), bf_hi(r.y)}; v[2 * j + 1] = (f32x4){bf_lo(r.z), bf_hi(r.z), bf_lo(r.w), bf_hi(r.w)};
                s += ((v[2 * j][0] * v[2 * j][0] + v[2 * j][1] * v[2 * j][1]) + (v[2 * j][2] * v[2 * j][2] + v[2 * j][3] * v[2 * j][3])) + ((v[2 * j + 1][0] * v[2 * j + 1][0] + v[2 * j + 1][1] * v[2 * j + 1][1]) + (v[2 * j + 1][2] * v[2 * j + 1][2] + v[2 * j + 1][3] * v[2 * j + 1][3])); }
            const float rstd = rsqrtf(wave_sum(s) * (1.0f / D) + RMS_EPS);
#pragma unroll
            for (int j = 0; j < 4; ++j) { const int c = 512 * j + 8 * lane; const f32x4 g0 = *(const f32x4*)(gr + c), g1 = *(const f32x4*)(gr + c + 4);
                *(f32x4*)(o + c) = v[2 * j] * rstd * g0; *(f32x4*)(o + c + 4) = v[2 * j + 1] * rstd * g1; }
        }
    }
#undef IN
#undef SEAM
}

extern "C" void kernel_launch(void* const* d_in, const int* in_sizes, int n_in, void* d_out, int out_size, void* d_ws, size_t ws_size, hipStream_t stream) {
    static int grid = 0;
    if (grid == 0) {
        if (n_in != N_IN || in_sizes[0] != T * D || out_size != T * D || ws_size < WS_END) {
            fprintf(stderr, "kernel_launch: unexpected problem (n_in %d, in0 %d, out %d, ws %zu; need ws >= %zu); nothing launched\n", n_in, n_in > 0 ? in_sizes[0] : -1, out_size, ws_size, (size_t)WS_END); grid = -1; return; }
        int dev = 0, cus = 0, per_cu = 0;
        if (hipGetDevice(&dev) != hipSuccess || hipDeviceGetAttribute(&cus, hipDeviceAttributeMultiprocessorCount, dev) != hipSuccess) { fprintf(stderr, "kernel_launch: device query failed\n"); grid = -1; return; }
        if (hipFuncSetAttribute((const void*)fwd_megakernel, hipFuncAttributeMaxDynamicSharedMemorySize, LDS_BYTES) != hipSuccess) { fprintf(stderr, "kernel_launch: hipFuncSetAttribute failed\n"); grid = -1; return; }
        if (hipOccupancyMaxActiveBlocksPerMultiprocessor(&per_cu, (const void*)fwd_megakernel, NTHR, LDS_BYTES) != hipSuccess || per_cu < 1) { fprintf(stderr, "kernel_launch: occupancy query says %d\n", per_cu); per_cu = 1; }
        (void)hipGetLastError();
        grid = cus * per_cu;
        fprintf(stderr, "kernel_launch: grid %d (cus %d x %d)\n", grid, cus, per_cu);
    }
    if (grid < 0) return;
    Args a{};
    for (int i = 0; i < N_IN; ++i) a.in[i] = (const float*)d_in[i];
    a.out = (float*)d_out; a.ws = (unsigned char*)d_ws;
    if (hipMemsetAsync((char*)d_ws + WS_CTL, 0, CTL_ZERO_BYTES, stream) != hipSuccess) { fprintf(stderr, "kernel_launch: memset of the control words failed\n"); return; }
#if MK_MULTI
    for (int ph = 0; ph < NPHASE; ++ph) for (int rep = 0; rep < (((MK_PROBE_MASK >> ph) & 1) ? 2 : 1); ++rep) { a.ph_lo = ph; a.ph_hi = ph + 1; a.coop = 0;
        hipLaunchKernelGGL(fwd_megakernel, dim3(grid), dim3(NTHR), LDS_BYTES, stream, a);
        const hipError_t le = hipPeekAtLastError(); if (le != hipSuccess) { fprintf(stderr, "kernel_launch: launch %d failed: %s\n", ph, hipGetErrorName(le)); break; } }
#else
    a.ph_lo = 0; a.ph_hi = NPHASE; a.coop = 1;
    void* kargs[] = {&a};
    const hipError_t e = hipLaunchCooperativeKernel((const void*)fwd_megakernel, dim3(grid), dim3(NTHR), kargs, LDS_BYTES, stream);
    if (e != hipSuccess) fprintf(stderr, "kernel_launch: cooperative launch failed: %s (grid %d)\n", hipGetErrorString(e), grid);
#endif
}
```

```cpp
#include <hip/hip_runtime.h>
#include <hip/hip_cooperative_groups.h>
#include <cstdio>
#include <cstdint>
namespace cg = cooperative_groups;

#ifndef MK_PROBE_MASK
#define MK_PROBE_MASK 0
#endif
#ifndef MK_MULTI
#define MK_MULTI 0
#endif

#define LAS __attribute__((address_space(3)))
typedef unsigned short bf16_t;
typedef short bf16x8 __attribute__((ext_vector_type(8)));
typedef float f32x4 __attribute__((ext_vector_type(4)));
typedef float f32x2 __attribute__((ext_vector_type(2)));
typedef unsigned u32x4 __attribute__((ext_vector_type(4)));
typedef unsigned u32x2 __attribute__((ext_vector_type(2)));

constexpr int T = 8192, D = 2048, FF = 5632, SEQ = 4096, NMEM = 256, CCH = 1024, NPART = 32;
constexpr float RMS_EPS = 1e-6f, LN_EPS = 1e-5f;
constexpr int NWAVES = 8, NTHR = 512;
constexpr int RING_BYTES = 131072, LDS_BYTES = 147456;
constexpr int NPHASE = 13;

constexpr size_t MiB = 1u << 20;
constexpr size_t WS_W1IN = 0, WS_W1OUT = 44 * MiB, WS_W2IN = 66 * MiB, WS_W2OUT = 110 * MiB, WS_WMIXIN = 132 * MiB, WS_WMIXOUT = 148 * MiB,
                 WS_WQ = 156 * MiB, WS_WKV = 164 * MiB, WS_WO = 180 * MiB, WS_WSGU = 188 * MiB, WS_MEMN = 189 * MiB, WS_KMAT = 191 * MiB,
                 WS_VT = 193 * MiB, WS_PART = 195 * MiB, WS_VSTAT = 196 * MiB, WS_XB = 197 * MiB, WS_XR = 229 * MiB, WS_ACT = 293 * MiB,
                 WS_CTL = 381 * MiB, WS_END = 382 * MiB;
constexpr size_t CTL_ZERO_BYTES = 32768;
constexpr size_t WS_AB = WS_ACT, WS_UB = WS_ACT + 16 * MiB, WS_VB = WS_ACT + 32 * MiB, WS_Y = WS_ACT + 48 * MiB;
constexpr size_t WS_Q = WS_ACT, WS_P = WS_ACT + 32 * MiB, WS_O = WS_ACT + 48 * MiB;

__device__ __forceinline__ unsigned cvt_pk_bf16(float lo, float hi) { unsigned r; asm volatile("v_cvt_pk_bf16_f32 %0, %1, %2" : "=v"(r) : "v"(lo), "v"(hi)); return r; }
__device__ __forceinline__ void st16_wt(void* p, u32x4 v) { asm volatile("global_store_dwordx4 %0, %1, off sc1\n\ts_nop 1" : : "v"(p), "v"(v) : "memory"); }
__device__ __forceinline__ float bf_lo(unsigned u) { return __uint_as_float(u << 16); }
__device__ __forceinline__ float bf_hi(unsigned u) { return __uint_as_float(u & 0xffff0000u); }
__device__ __forceinline__ float wave_sum(float v) {
#pragma unroll
    for (int o = 1; o < 64; o <<= 1) v += __shfl_xor(v, o);
    return v;
}
__device__ __forceinline__ float fast_exp2(float x) { return __builtin_amdgcn_exp2f(x); }
__device__ __forceinline__ float fast_rcp(float x) { return __builtin_amdgcn_rcpf(x); }
__device__ __forceinline__ float sigmoidf_(float x) { return fast_rcp(1.0f + fast_exp2(-1.4426950408889634f * x)); }
__device__ __forceinline__ f32x2 gelu_pk(f32x2 v) {
    const f32x2 av = __builtin_elementwise_abs(v), d = av * 0.2316418882f + 1.0f;
    f32x2 t; t.x = __builtin_amdgcn_rcpf(d.x); t.y = __builtin_amdgcn_rcpf(d.y);
    f32x2 q = t * 0.5307027145f + (-0.7265760135f); q = q * t + 0.7107068705f; q = q * t + (-0.142248368f); q = q * t + 0.127414796f; q = q * t;
    const f32x2 s = (v * v) * (-0.72134752044f);
    f32x2 e; e.x = __builtin_amdgcn_exp2f(s.x); e.y = __builtin_amdgcn_exp2f(s.y);
    const f32x2 m = v * (q * e), r = v - m;
    f32x2 o; o.x = v.x < 0.f ? m.x : r.x; o.y = v.y < 0.f ? m.y : r.y; return o;
}
__device__ __forceinline__ f32x4 gelu4(f32x4 v) { f32x2 a = gelu_pk((f32x2){v[0], v[1]}), b = gelu_pk((f32x2){v[2], v[3]}); return (f32x4){a.x, a.y, b.x, b.y}; }

namespace pg8 {
constexpr int BM = 256, BK = 64, HALF = 128, HTB = HALF * BK * 2, STAGE_BYTES = 8 * HTB, NXCD = 8, WGM = 8;
__host__ __device__ __forceinline__ int lds_byte(int r, int c) { const int st = (r >> 4) * 2 + (c >> 5), rr = r & 15, cc = c & 31, ob = rr * 64 + cc * 2; return st * 1024 + (ob ^ (((ob >> 9) & 1) << 5)); }
__host__ __device__ __forceinline__ void stage_rc(int b, int& R, int& C) { const int st = b / 1024, sb = b % 1024, swz = sb ^ (((sb >> 9) & 1) << 5); R = (st >> 1) * 16 + swz / 64; C = (st & 1) * 32 + (swz % 64) / 2; }
__host__ __device__ __forceinline__ int perm32(int rho) { const int n = rho >> 4, i = rho & 15; return 8 * (i >> 2) + 4 * n + (i & 3); }

struct Unit { int pm, pn; unsigned aoff, boff; };
struct Gemm { const bf16_t* A; const bf16_t* Bt; int lda, ldb, K; };

struct StaticOrder {
    int nM, nN, nwg, G, c;
    __device__ __forceinline__ void init(int M, int N, int G_, int c_) { nM = M / BM; nN = N / BM; nwg = nM * nN; G = G_; c = c_; }
    __device__ __forceinline__ bool next(int i, int& pm, int& pn) const {
        const long L = (long)i * G + c; if (L >= nwg) return false;
        int wgid = (int)L; { const int q = nwg / NXCD, r = nwg % NXCD, xcd = wgid % NXCD, off = wgid / NXCD; wgid = (xcd < r ? xcd * (q + 1) : r * (q + 1) + (xcd - r) * q) + off; }
        const int nig = WGM * nN, gid = wgid / nig, fm = gid * WGM, gsz = (nM - fm) < WGM ? (nM - fm) : WGM;
        pm = fm + ((wgid % nig) % gsz); pn = (wgid % nig) / gsz; return true;
    }
};
struct PlainOrder {
    StaticOrder so; int lda, ldb;
    __device__ void init(int M, int N, int G, int c, int lda_, int ldb_) { so.init(M, N, G, c); lda = lda_; ldb = ldb_; }
    __device__ bool next(int i, Unit& u) const { int pm, pn; if (!so.next(i, pm, pn)) return false; u.pm = pm; u.pn = pn; u.aoff = (unsigned)pm * BM * lda; u.boff = (unsigned)pn * BM * ldb; return true; }
};
struct BatchBOrder {
    StaticOrder so; int lda, ldb; unsigned bstride;
    __device__ __forceinline__ void init(int M, int N, int G, int c, int lda_, int ldb_, unsigned bs) { so.init(M, N, G, c); lda = lda_; ldb = ldb_; bstride = bs; }
    __device__ __forceinline__ bool next(int i, Unit& u) const { int pm, pn; if (!so.next(i, pm, pn)) return false; u.pm = pm; u.pn = pn; u.aoff = (unsigned)pm * BM * lda; u.boff = (unsigned)(pm >> 4) * bstride + (unsigned)pn * BM * ldb; return true; }
};
struct MixOrder {
    StaticOrder so; int lda, ldb;
    __device__ __forceinline__ void init(int M, int N, int G, int c, int lda_, int ldb_) { so.init(M, N, G, c); lda = lda_; ldb = ldb_; }
    __device__ __forceinline__ bool next(int i, Unit& u) const { int pm, pn; if (!so.next(i, pm, pn)) return false; u.pm = pm; u.pn = ((pn & 12) == 4 || (pn & 12) == 8) ? (pn ^ 12) : pn; u.aoff = (unsigned)pm * BM * lda; u.boff = (unsigned)pn * BM * ldb; return true; }
};
struct OneUnit { Unit u; __device__ bool next(int i, Unit& o) const { if (i) return false; o = u; return true; } };
struct PVOrder {
    int G, c;
    __device__ bool next(int i, Unit& u) const { const int L = i * G + c; if (L >= 256) return false; const int pn = L & 1, h = (L >> 1) & 3, pm = L >> 3;
        u.pm = pm; u.pn = 2 * h + pn; u.aoff = (unsigned)pm * 256 * 1024 + h * 256; u.boff = (unsigned)(h * 512 + pn * 256) * 512 + (pm >> 4) * 256; return true; }
};

__device__ __forceinline__ void load_rstd(const float* part, int row0, int fq, float (&rs)[2][4]) {
#pragma unroll
    for (int ai = 0; ai < 2; ++ai)
#pragma unroll
        for (int m = 0; m < 4; ++m) { const float* p = part + (size_t)(row0 + ai * HALF + m * 16) * NPART + fq * 8;
            const f32x4 a = *(const f32x4*)p, b = *(const f32x4*)(p + 4); float s = ((a[0] + a[1]) + (a[2] + a[3])) + ((b[0] + b[1]) + (b[2] + b[3]));
            s += __shfl_xor(s, 16); s += __shfl_xor(s, 32); rs[ai][m] = rsqrtf(s * (1.0f / D) + RMS_EPS); }
}

struct EpiBf16S {
    static constexpr bool PERM = true, AFTER_DRAIN = false;
    bf16_t* O; int ldc; const float* part; float mul;
    __device__ __forceinline__ void operator()(const f32x4 (&acc)[2][2][4][2], const Unit& u, int wr, int wc, int fr, int fq) const {
        const int row0 = u.pm * BM + wr * 64 + fr, col0 = u.pn * BM + wc * 32 + 8 * fq;
        float rs[2][4];
        if (part) load_rstd(part, row0, fq, rs);
#pragma unroll
        for (int ai = 0; ai < 2; ++ai)
#pragma unroll
            for (int m = 0; m < 4; ++m) { const float sc = part ? rs[ai][m] * mul : mul; bf16_t* rowp = O + (size_t)(row0 + ai * HALF + m * 16) * ldc + col0;
#pragma unroll
                for (int bj = 0; bj < 2; ++bj) { const f32x4 v0 = acc[ai][bj][m][0] * sc, v1 = acc[ai][bj][m][1] * sc; u32x4 w;
                    w.x = cvt_pk_bf16(v0[0], v0[1]); w.y = cvt_pk_bf16(v0[2], v0[3]); w.z = cvt_pk_bf16(v1[0], v1[1]); w.w = cvt_pk_bf16(v1[2], v1[3]);
                    *(u32x4*)(rowp + bj * HALF) = w; } }
    }
};
struct EpiBf16Pub {
    static constexpr bool PERM = true, AFTER_DRAIN = false;
    bf16_t* O; int ldc; unsigned* cnt;
    __device__ __forceinline__ void operator()(const f32x4 (&acc)[2][2][4][2], const Unit& u, int wr, int wc, int fr, int fq) const {
        const int row0 = u.pm * BM + wr * 64 + fr, col0 = u.pn * BM + wc * 32 + 8 * fq;
#pragma unroll
        for (int ai = 0; ai < 2; ++ai)
#pragma unroll
            for (int m = 0; m < 4; ++m) { bf16_t* rowp = O + (size_t)(row0 + ai * HALF + m * 16) * ldc + col0;
#pragma unroll
                for (int bj = 0; bj < 2; ++bj) { const f32x4 v0 = acc[ai][bj][m][0], v1 = acc[ai][bj][m][1]; u32x4 w;
                    w.x = cvt_pk_bf16(v0[0], v0[1]); w.y = cvt_pk_bf16(v0[2], v0[3]); w.z = cvt_pk_bf16(v1[0], v1[1]); w.w = cvt_pk_bf16(v1[2], v1[3]);
                    st16_wt(rowp + bj * HALF, w); } }
        asm volatile("s_waitcnt vmcnt(0)" ::: "memory");
        if ((threadIdx.x & 63) == 0) __hip_atomic_fetch_add(cnt, 1u, __ATOMIC_RELAXED, __HIP_MEMORY_SCOPE_AGENT);
    }
};
struct EpiSwiGLU {
    static constexpr bool PERM = true, AFTER_DRAIN = false;
    bf16_t* O; const float* part;
    __device__ __forceinline__ void operator()(const f32x4 (&acc)[2][2][4][2], const Unit& u, int wr, int wc, int fr, int fq) const {
        const int row0 = u.pm * BM + wr * 64 + fr, col0 = u.pn * HALF + wc * 32 + 8 * fq;
        float rs[2][4]; load_rstd(part, row0, fq, rs);
#pragma unroll
        for (int ai = 0; ai < 2; ++ai)
#pragma unroll
            for (int m = 0; m < 4; ++m) { const float sc = rs[ai][m]; f32x4 o[2];
#pragma unroll
                for (int n = 0; n < 2; ++n) { const f32x4 g = acc[ai][0][m][n] * sc, up = acc[ai][1][m][n] * sc;
#pragma unroll
                    for (int e = 0; e < 4; ++e) o[n][e] = g[e] * sigmoidf_(g[e]) * up[e]; }
                u32x4 w; w.x = cvt_pk_bf16(o[0][0], o[0][1]); w.y = cvt_pk_bf16(o[0][2], o[0][3]); w.z = cvt_pk_bf16(o[1][0], o[1][1]); w.w = cvt_pk_bf16(o[1][2], o[1][3]);
                *(u32x4*)(O + (size_t)(row0 + ai * HALF + m * 16) * FF + col0) = w; }
    }
};
struct EpiMixIn {
    static constexpr bool PERM = true, AFTER_DRAIN = false;
    bf16_t *AB, *UB, *VB; float* vstat; const float* part;
    __device__ __forceinline__ void operator()(const f32x4 (&acc)[2][2][4][2], const Unit& u, int wr, int wc, int fr, int fq) const {
        const int row0 = u.pm * BM + wr * 64 + fr;
        float rs[2][4]; load_rstd(part, row0, fq, rs);
        if (u.pn < 8) {
            const int col0 = u.pn * HALF + wc * 32 + 8 * fq;
#pragma unroll
            for (int ai = 0; ai < 2; ++ai)
#pragma unroll
                for (int m = 0; m < 4; ++m) { const float sc = rs[ai][m]; f32x4 o[2];
#pragma unroll
                    for (int n = 0; n < 2; ++n) { const f32x4 v = acc[ai][0][m][n] * sc, g = acc[ai][1][m][n] * sc;
#pragma unroll
                        for (int e = 0; e < 4; ++e) o[n][e] = v[e] * sigmoidf_(g[e]); }
                    u32x4 w; w.x = cvt_pk_bf16(o[0][0], o[0][1]); w.y = cvt_pk_bf16(o[0][2], o[0][3]); w.z = cvt_pk_bf16(o[1][0], o[1][1]); w.w = cvt_pk_bf16(o[1][2], o[1][3]);
                    *(u32x4*)(AB + (size_t)(row0 + ai * HALF + m * 16) * CCH + col0) = w; }
        } else {
            const bool isv = u.pn >= 12; bf16_t* dst = isv ? VB : UB; const int tq = isv ? u.pn - 12 : u.pn - 8;
            const int col0 = tq * BM + wc * 32 + 8 * fq;
#pragma unroll
            for (int ai = 0; ai < 2; ++ai)
#pragma unroll
                for (int m = 0; m < 4; ++m) { const float sc = rs[ai][m]; const int row = row0 + ai * HALF + m * 16; float s1 = 0.f, s2 = 0.f;
#pragma unroll
                    for (int bj = 0; bj < 2; ++bj) { const f32x4 v0 = gelu4(acc[ai][bj][m][0] * sc), v1 = gelu4(acc[ai][bj][m][1] * sc);
                        s1 += ((v0[0] + v0[1]) + (v0[2] + v0[3])) + ((v1[0] + v1[1]) + (v1[2] + v1[3]));
                        s2 += ((v0[0] * v0[0] + v0[1] * v0[1]) + (v0[2] * v0[2] + v0[3] * v0[3])) + ((v1[0] * v1[0] + v1[1] * v1[1]) + (v1[2] * v1[2] + v1[3] * v1[3]));
                        u32x4 w; w.x = cvt_pk_bf16(v0[0], v0[1]); w.y = cvt_pk_bf16(v0[2], v0[3]); w.z = cvt_pk_bf16(v1[0], v1[1]); w.w = cvt_pk_bf16(v1[2], v1[3]);
                        *(u32x4*)(dst + (size_t)row * CCH + col0 + bj * HALF) = w; }
                    if (isv) { s1 += __shfl_xor(s1, 16); s1 += __shfl_xor(s1, 32); s2 += __shfl_xor(s2, 16); s2 += __shfl_xor(s2, 32);
                        if (fq == 0) *(f32x2*)(vstat + ((size_t)row * 16 + tq * 4 + wc) * 2) = (f32x2){s1, s2}; } }
        }
    }
};
struct EpiResid {
    static constexpr bool PERM = true, AFTER_DRAIN = false;
    bf16_t* XB; float* part; float alpha;
    __device__ __forceinline__ void operator()(const f32x4 (&acc)[2][2][4][2], const Unit& u, int wr, int wc, int fr, int fq) const {
        const int row0 = u.pm * BM + wr * 64 + fr, col0 = u.pn * BM + wc * 32 + 8 * fq;
#pragma unroll
        for (int ai = 0; ai < 2; ++ai)
#pragma unroll
            for (int m = 0; m < 4; ++m) { const int row = row0 + ai * HALF + m * 16; bf16_t* rowp = XB + (size_t)row * D + col0; float ss = 0.f;
#pragma unroll
                for (int bj = 0; bj < 2; ++bj) { const u32x4 r = *(const u32x4*)(rowp + bj * HALF);
                    const f32x4 o0 = (f32x4){bf_lo(r.x), bf_hi(r.x), bf_lo(r.y), bf_hi(r.y)} + acc[ai][bj][m][0] * alpha, o1 = (f32x4){bf_lo(r.z), bf_hi(r.z), bf_lo(r.w), bf_hi(r.w)} + acc[ai][bj][m][1] * alpha;
                    ss += ((o0[0] * o0[0] + o0[1] * o0[1]) + (o0[2] * o0[2] + o0[3] * o0[3])) + ((o1[0] * o1[0] + o1[1] * o1[1]) + (o1[2] * o1[2] + o1[3] * o1[3]));
                    u32x4 w; w.x = cvt_pk_bf16(o0[0], o0[1]); w.y = cvt_pk_bf16(o0[2], o0[3]); w.z = cvt_pk_bf16(o1[0], o1[1]); w.w = cvt_pk_bf16(o1[2], o1[3]);
                    *(u32x4*)(rowp + bj * HALF) = w; }
                ss += __shfl_xor(ss, 16); ss += __shfl_xor(ss, 32);
                if (fq == 0) part[(size_t)row * NPART + u.pn * 4 + wc] = ss; }
    }
};
struct EpiFinal {
    static constexpr bool PERM = true, AFTER_DRAIN = false;
    const bf16_t* XB; float* part; unsigned* cnt; const float* gain; float* out; float alpha; LAS float* R;
    __device__ __forceinline__ void operator()(f32x4 (&acc)[2][2][4][2], const Unit& u, int wr, int wc, int fr, int fq) const {
        const int row0 = u.pm * BM + wr * 64 + fr, col0 = u.pn * BM + wc * 32 + 8 * fq;
#pragma unroll
        for (int ai = 0; ai < 2; ++ai)
#pragma unroll
            for (int m = 0; m < 4; ++m) { const int row = row0 + ai * HALF + m * 16; const bf16_t* rowp = XB + (size_t)row * D + col0; float ss = 0.f;
#pragma unroll
                for (int bj = 0; bj < 2; ++bj) { const u32x4 r = *(const u32x4*)(rowp + bj * HALF);
                    const f32x4 o0 = (f32x4){bf_lo(r.x), bf_hi(r.x), bf_lo(r.y), bf_hi(r.y)} + acc[ai][bj][m][0] * alpha, o1 = (f32x4){bf_lo(r.z), bf_hi(r.z), bf_lo(r.w), bf_hi(r.w)} + acc[ai][bj][m][1] * alpha;
                    ss += ((o0[0] * o0[0] + o0[1] * o0[1]) + (o0[2] * o0[2] + o0[3] * o0[3])) + ((o1[0] * o1[0] + o1[1] * o1[1]) + (o1[2] * o1[2] + o1[3] * o1[3]));
                    acc[ai][bj][m][0] = o0; acc[ai][bj][m][1] = o1; }
                ss += __shfl_xor(ss, 16); ss += __shfl_xor(ss, 32);
                if (fq == 0) __hip_atomic_store(part + (size_t)row * NPART + u.pn * 4 + wc, ss, __ATOMIC_RELAXED, __HIP_MEMORY_SCOPE_AGENT); }
        asm volatile("s_waitcnt vmcnt(0)" ::: "memory");
        unsigned* c = cnt + 64 * u.pm;
        if ((threadIdx.x & 63) == 0) __hip_atomic_fetch_add(c, 1u, __ATOMIC_RELAXED, __HIP_MEMORY_SCOPE_AGENT);
        if (threadIdx.x < 256) {
            unsigned sp = 0;
            while ((unsigned)__builtin_amdgcn_readfirstlane(__hip_atomic_load(c, __ATOMIC_RELAXED, __HIP_MEMORY_SCOPE_AGENT)) < 64u) { __builtin_amdgcn_s_sleep(4); if (++sp > (1u << 21)) break; }
            __builtin_amdgcn_fence(__ATOMIC_ACQUIRE, "agent");
            const unsigned long long* p = (const unsigned long long*)(part + (size_t)(u.pm * BM + threadIdx.x) * NPART); float s = 0.f;
#pragma unroll
            for (int j = 0; j < 16; ++j) { const unsigned long long w = __hip_atomic_load(p + j, __ATOMIC_RELAXED, __HIP_MEMORY_SCOPE_AGENT); s += __uint_as_float((unsigned)w) + __uint_as_float((unsigned)(w >> 32)); }
            R[threadIdx.x] = rsqrtf(s * (1.0f / D) + RMS_EPS);
        }
        asm volatile("s_waitcnt vmcnt(0) lgkmcnt(0)" ::: "memory"); __builtin_amdgcn_s_barrier(); asm volatile("" ::: "memory");
#pragma unroll
        for (int ai = 0; ai < 2; ++ai)
#pragma unroll
            for (int m = 0; m < 4; ++m) { const int rl = ai * HALF + wr * 64 + m * 16 + fr; const float rstd = R[rl]; float* orow = out + (size_t)(u.pm * BM + rl) * D + col0;
#pragma unroll
                for (int bj = 0; bj < 2; ++bj) { const f32x4 g0 = *(const f32x4*)(gain + col0 + bj * HALF), g1 = *(const f32x4*)(gain + col0 + bj * HALF + 4);
                    *(f32x4*)(orow + bj * HALF) = acc[ai][bj][m][0] * rstd * g0; *(f32x4*)(orow + bj * HALF + 4) = acc[ai][bj][m][1] * rstd * g1; } }
    }
};
struct EpiSoftmax {
    static constexpr bool PERM = true, AFTER_DRAIN = true;
    bf16_t* P; const float* part; float mul;
    __device__ __forceinline__ void fused(f32x4 (&acc)[2][2][4][2], const Unit& u, int wr, int wc, int fr, int fq, LAS unsigned char* lds, int wid, int lane) const {
        LAS f32x2* X = (LAS f32x2*)lds;
        float mw[2][4]; float rs[2][4]; load_rstd(part, u.pm * BM + wr * 64 + fr, fq, rs);
#pragma unroll
        for (int ai = 0; ai < 2; ++ai)
#pragma unroll
            for (int m = 0; m < 4; ++m) {
                float mx = -3.0e38f;
#pragma unroll
                for (int bj = 0; bj < 2; ++bj)
#pragma unroll
                    for (int n = 0; n < 2; ++n) { const f32x4 a = acc[ai][bj][m][n] * (rs[ai][m] * mul); acc[ai][bj][m][n] = a; mx = fmaxf(mx, fmaxf(fmaxf(a[0], a[1]), fmaxf(a[2], a[3]))); }
                mx = fmaxf(mx, __shfl_xor(mx, 16)); mx = fmaxf(mx, __shfl_xor(mx, 32));
                float s = 0.f;
#pragma unroll
                for (int bj = 0; bj < 2; ++bj)
#pragma unroll
                    for (int n = 0; n < 2; ++n) { f32x4 a = acc[ai][bj][m][n];
#pragma unroll
                        for (int e = 0; e < 4; ++e) { a[e] = fast_exp2(a[e] - mx); s += a[e]; }
                        acc[ai][bj][m][n] = a; }
                s += __shfl_xor(s, 16); s += __shfl_xor(s, 32);
                mw[ai][m] = mx;
                if (fq == 0) X[(ai * HALF + wr * 64 + m * 16 + fr) * 4 + wc] = (f32x2){mx, s};
            }
        asm volatile("s_waitcnt lgkmcnt(0)" ::: "memory"); __builtin_amdgcn_s_barrier(); asm volatile("" ::: "memory");
#pragma unroll
        for (int ai = 0; ai < 2; ++ai)
#pragma unroll
            for (int m = 0; m < 4; ++m) { const int r = ai * HALF + wr * 64 + m * 16 + fr;
                const f32x4 p01 = *(const LAS f32x4*)(X + r * 4), p23 = *(const LAS f32x4*)(X + r * 4 + 2);
                const float M = fmaxf(fmaxf(p01[0], p01[2]), fmaxf(p23[0], p23[2]));
                const float tot = (p01[1] * fast_exp2(p01[0] - M) + p01[3] * fast_exp2(p01[2] - M)) + (p23[1] * fast_exp2(p23[0] - M) + p23[3] * fast_exp2(p23[2] - M));
                const float f = fast_exp2(mw[ai][m] - M) / tot;
                bf16_t* rowp = P + (size_t)(u.pm * BM + r) * 1024 + u.pn * BM + wc * 32 + 8 * fq;
#pragma unroll
                for (int bj = 0; bj < 2; ++bj) { const f32x4 v0 = acc[ai][bj][m][0] * f, v1 = acc[ai][bj][m][1] * f; u32x4 w;
                    w.x = cvt_pk_bf16(v0[0], v0[1]); w.y = cvt_pk_bf16(v0[2], v0[3]); w.z = cvt_pk_bf16(v1[0], v1[1]); w.w = cvt_pk_bf16(v1[2], v1[3]);
                    *(u32x4*)(rowp + bj * HALF) = w; } }
        asm volatile("s_waitcnt lgkmcnt(0)" ::: "memory"); __builtin_amdgcn_s_barrier(); asm volatile("" ::: "memory");
    }
};

template <class Epi, class Sched, bool ALIGN_EPI>
__device__ __forceinline__ void gemm_phase(LAS unsigned char* lds, const Gemm g, const Sched& S, const Epi& E) {
    const int tid = threadIdx.x, wid = __builtin_amdgcn_readfirstlane(tid >> 6), lane = tid & 63, wr = wid >> 2, wc = wid & 3, fr = lane & 15, fq = lane >> 4;
    const int K = g.K, nt = K / BK;
    unsigned voffA[2], voffB[2];
#pragma unroll
    for (int i = 0; i < 2; ++i) { int R, C; stage_rc(tid * 16 + i * 8192, R, C); const int Rb = Epi::PERM ? ((R & ~31) + perm32(R & 31)) : R;
        voffA[i] = (unsigned)(R * g.lda + C) * 2u; voffB[i] = (unsigned)(Rb * g.ldb + C) * 2u; }
    const size_t kstep = (size_t)(BK * 2);
    const size_t hA = (size_t)HALF * g.lda * 2, hB = (size_t)HALF * g.ldb * 2;
    const unsigned ldsw = (unsigned)wid * 1024u;
    const int aoff = lds_byte(wr * 64 + fr, fq * 8), boff = lds_byte(wc * 32 + fr, fq * 8);
#define PG8_SA(b, h) (((b) * 2 + (h)) * HTB)
#define PG8_SB(b, h) ((4 + (b) * 2 + (h)) * HTB)
#define PG8_STAGE(bufoff, gbase, voff) do { _Pragma("unroll") for (int _i = 0; _i < 2; ++_i) \
        __builtin_amdgcn_global_load_lds((const unsigned*)((const char*)(gbase) + (voff)[_i]), (LAS unsigned*)(lds + (bufoff) + ldsw + _i * 8192), 16, 0, 0); } while (0)
#define PG8_LDA(dst, b, h) do { _Pragma("unroll") for (int m = 0; m < 4; ++m) _Pragma("unroll") for (int k = 0; k < 2; ++k) dst[m][k] = *(const LAS bf16x8*)(lds + PG8_SA(b, h) + aoff + m * 2048 + k * 1024); } while (0)
#define PG8_LDB(dst, b, h) do { _Pragma("unroll") for (int n = 0; n < 2; ++n) _Pragma("unroll") for (int k = 0; k < 2; ++k) dst[n][k] = *(const LAS bf16x8*)(lds + PG8_SB(b, h) + boff + n * 2048 + k * 1024); } while (0)
#define PG8_MMA(ai, bj, At, Bt) do { __builtin_amdgcn_s_setprio(1); _Pragma("unroll") for (int m = 0; m < 4; ++m) _Pragma("unroll") for (int n = 0; n < 2; ++n) _Pragma("unroll") for (int k = 0; k < 2; ++k) \
        acc[ai][bj][m][n] = __builtin_amdgcn_mfma_f32_16x16x32_bf16(Bt[n][k], At[m][k], acc[ai][bj][m][n], 0, 0, 0); __builtin_amdgcn_s_setprio(0); } while (0)
#define PG8_WAIT_V(n) asm volatile("s_waitcnt vmcnt(" #n ")" ::: "memory")
#define PG8_WAIT_L(n) asm volatile("s_waitcnt lgkmcnt(" #n ")" ::: "memory")
#define PG8_BAR __builtin_amdgcn_s_barrier()
#define PG8_SCHED __builtin_amdgcn_sched_barrier(0)
    Unit cur, nxt; int ui = 0;
    if (!S.next(0, cur)) return;
    f32x4 acc[2][2][4][2];
#pragma unroll
    for (int a = 0; a < 2; ++a)
#pragma unroll
        for (int b = 0; b < 2; ++b)
#pragma unroll
            for (int m = 0; m < 4; ++m)
#pragma unroll
                for (int n = 0; n < 2; ++n) acc[a][b][m][n] = (f32x4){0.f, 0.f, 0.f, 0.f};
    bf16x8 At[4][2], B0[2][2], B1[2][2];
    const char* cA = (const char*)g.A + (size_t)cur.aoff * 2; const char* cB = (const char*)g.Bt + (size_t)cur.boff * 2;
    PG8_STAGE(PG8_SB(0, 0), cB, voffB); PG8_STAGE(PG8_SB(0, 1), cB + hB, voffB); PG8_STAGE(PG8_SA(0, 0), cA, voffA); PG8_STAGE(PG8_SA(0, 1), cA + hA, voffA);
    if (wr == 1) PG8_BAR;
    PG8_WAIT_V(2); PG8_BAR;
    PG8_STAGE(PG8_SB(1, 0), cB + kstep, voffB); PG8_STAGE(PG8_SA(1, 0), cA + kstep, voffA); PG8_STAGE(PG8_SB(1, 1), cB + hB + kstep, voffB);
    PG8_WAIT_V(6); PG8_BAR;
    for (;;) {
        const bool has_next = S.next(ui + 1, nxt);
        const char* nA = has_next ? (const char*)g.A + (size_t)nxt.aoff * 2 : cA; const char* nB = has_next ? (const char*)g.Bt + (size_t)nxt.boff * 2 : cB;
        for (int t = 0; t < nt; t += 2) {
            const bool last = (t == nt - 2);
            const char* a1 = cA + (size_t)(t + 1) * kstep;
            const char* a2 = last ? nA : cA + (size_t)(t + 2) * kstep; const char* b2 = last ? nB : cB + (size_t)(t + 2) * kstep;
            const char* a3 = a2 + kstep; const char* b3 = b2 + kstep;
            PG8_LDB(B0, 0, 0); PG8_LDB(B1, 0, 1); PG8_SCHED; PG8_LDA(At, 0, 0); PG8_STAGE(PG8_SA(1, 1), a1 + hA, voffA);
            PG8_WAIT_V(8); PG8_WAIT_L(0); PG8_BAR; PG8_MMA(0, 0, At, B0); PG8_MMA(0, 1, At, B1); PG8_BAR; PG8_SCHED;
            PG8_LDA(At, 0, 1); PG8_STAGE(PG8_SB(0, 0), b2, voffB); PG8_STAGE(PG8_SB(0, 1), b2 + hB, voffB); PG8_STAGE(PG8_SA(0, 0), a2, voffA);
            PG8_WAIT_V(8); PG8_WAIT_L(0); PG8_BAR; PG8_MMA(1, 0, At, B0); PG8_MMA(1, 1, At, B1); PG8_BAR; PG8_SCHED;
            PG8_LDB(B0, 1, 0); PG8_LDB(B1, 1, 1); PG8_SCHED; PG8_LDA(At, 1, 0); PG8_STAGE(PG8_SA(0, 1), a2 + hA, voffA);
            PG8_WAIT_V(8); PG8_WAIT_L(0); PG8_BAR; PG8_MMA(0, 0, At, B0); PG8_MMA(0, 1, At, B1); PG8_BAR; PG8_SCHED;
            PG8_LDA(At, 1, 1); PG8_STAGE(PG8_SB(1, 0), b3, voffB); PG8_STAGE(PG8_SB(1, 1), b3 + hB, voffB); PG8_STAGE(PG8_SA(1, 0), a3, voffA);
            PG8_WAIT_V(8); PG8_WAIT_L(0); PG8_BAR; PG8_MMA(1, 0, At, B0); PG8_MMA(1, 1, At, B1); PG8_BAR; PG8_SCHED;
        }
        if constexpr (ALIGN_EPI) { if (wr == 0) PG8_BAR; }
        if constexpr (!Epi::AFTER_DRAIN) { E(acc, cur, wr, wc, fr, fq); }
        if (!has_next) break;
#pragma unroll
        for (int a = 0; a < 2; ++a)
#pragma unroll
            for (int b = 0; b < 2; ++b)
#pragma unroll
                for (int m = 0; m < 4; ++m)
#pragma unroll
                    for (int n = 0; n < 2; ++n) acc[a][b][m][n] = (f32x4){0.f, 0.f, 0.f, 0.f};
        cur = nxt; cA = nA; cB = nB; ++ui;
        if constexpr (ALIGN_EPI) { if (wr == 1) PG8_BAR; }
    }
    PG8_WAIT_V(0);
    if constexpr (!ALIGN_EPI) { if (wr == 0) PG8_BAR; }
    PG8_BAR;
    if constexpr (Epi::AFTER_DRAIN) { E.fused(acc, cur, wr, wc, fr, fq, lds, wid, lane); }
#undef PG8_SA
#undef PG8_SB
#undef PG8_STAGE
#undef PG8_LDA
#undef PG8_LDB
#undef PG8_MMA
#undef PG8_WAIT_V
#undef PG8_WAIT_L
#undef PG8_BAR
#undef PG8_SCHED
}
}

#define XB_TMO      128
#define XB_XCNT(j)  (256  + 64 * (j))
#define XB_XSUB(j)  (1280 + 64 * (j))
#define XB_XGEN(j)  (2304 + 64 * (j))
#define XB_TOP      3328
#define XB_TOPGEN   3392
#define XCD_BAR_WORDS 3456
#define XB_SPIN_CAP (1u << 18)
__device__ __forceinline__ unsigned xb_ld(unsigned* p)              { return __hip_atomic_load(p, __ATOMIC_RELAXED, __HIP_MEMORY_SCOPE_AGENT); }
__device__ __forceinline__ unsigned xb_add(unsigned* p, unsigned v) { return __hip_atomic_fetch_add(p, v, __ATOMIC_RELAXED, __HIP_MEMORY_SCOPE_AGENT); }
__device__ __forceinline__ unsigned xb_xcc_id() { return (unsigned)__builtin_amdgcn_s_getreg((3 << 11) | 20) & 0xFu; }
#define XB_SPIN(cond, bar) do { unsigned _sp = 0; while (cond) { __builtin_amdgcn_s_sleep(1); \
    if ((++_sp & 255u) == 0u) { if (xb_ld(&(bar)[XB_TMO])) break; if (_sp > XB_SPIN_CAP) { atomicAdd(&(bar)[XB_TMO], 1u); break; } } } } while (0)
struct XcdBarrier { unsigned* bar; unsigned x; volatile LAS unsigned* st; };
__device__ __forceinline__ XcdBarrier xcd_barrier_post(unsigned* bar, volatile LAS unsigned* st) {
    XcdBarrier b; b.bar = bar; b.x = xb_xcc_id(); b.st = st;
    if (threadIdx.x == 0) (void)xb_add(&bar[XB_XCNT(b.x)], 1u);
    return b;
}
__device__ __forceinline__ void xcd_barrier_complete(unsigned* bar, unsigned x, unsigned& nloc, unsigned& nx) {
    const unsigned G = gridDim.x * gridDim.y * gridDim.z;
    unsigned sum, cnt, mine, sp = 0u;
    for (;;) {
        sum = 0u; cnt = 0u; mine = 0u;
#pragma unroll
        for (unsigned j = 0; j < 16; ++j) { const unsigned c = xb_ld(&bar[XB_XCNT(j)]); sum += c; cnt += (c > 0u) ? 1u : 0u; mine = (j == x) ? c : mine; }
        if (sum == G) break;
        __builtin_amdgcn_s_sleep(1);
        if ((++sp & 255u) == 0u) { if (xb_ld(&bar[XB_TMO])) break; if (sp > XB_SPIN_CAP) { atomicAdd(&bar[XB_TMO], 1u); break; } }
    }
    nloc = mine > 0u ? mine : 1u; nx = cnt > 0u ? cnt : 1u;
}
__device__ __forceinline__ void xcd_barrier(const XcdBarrier& b) {
    asm volatile("s_waitcnt vmcnt(0)" ::: "memory");
    __syncthreads();
    if (threadIdx.x == 0) {
        unsigned* bar = b.bar;
        __builtin_amdgcn_s_waitcnt(0);
        unsigned nloc = b.st[0], nx = b.st[1];
        if (nloc == 0u) { xcd_barrier_complete(bar, b.x, nloc, nx); b.st[0] = nloc; b.st[1] = nx; }
        const unsigned old = xb_add(&bar[XB_XSUB(b.x)], 1u);
        const unsigned gen = old / nloc;
        if (old + 1u == (gen + 1u) * nloc) {
            __builtin_amdgcn_fence(__ATOMIC_RELEASE, "agent");
            asm volatile("s_waitcnt vmcnt(0)" ::: "memory");
            const unsigned og = xb_add(&bar[XB_TOP], 1u);
            const unsigned tg = og / nx;
            if (og + 1u == (tg + 1u) * nx) xb_add(&bar[XB_TOPGEN], 1u);
            else XB_SPIN(xb_ld(&bar[XB_TOPGEN]) == tg, bar);
            __builtin_amdgcn_fence(__ATOMIC_ACQUIRE, "agent");
            xb_add(&bar[XB_XGEN(b.x)], 1u);
            asm volatile("s_waitcnt vmcnt(0)" ::: "memory");
        } else {
            XB_SPIN(xb_ld(&bar[XB_XGEN(b.x)]) == gen, bar);
            __builtin_amdgcn_fence(__ATOMIC_ACQUIRE, "agent");
            asm volatile("s_waitcnt vmcnt(0)" ::: "memory");
        }
    }
    __syncthreads();
}

enum { I_X = 0, I_MEM, I_FFN1_NORM, I_FFN1_WIN, I_FFN1_WOUT, I_MIX_NORM, I_WMIXIN, I_CONV_W, I_CONV_B, I_CONV_LN_G, I_CONV_LN_B, I_SGU_LN_G, I_SGU_LN_B, I_SGU_W, I_SGU_B,
       I_OUT_NORM_CONV, I_OUT_NORM_SGU, I_WMIXOUT, I_XATTN_NORM, I_MEM_NORM, I_WQ, I_WKV, I_WO, I_FFN2_NORM, I_FFN2_WIN, I_FFN2_WOUT, I_FINAL_NORM, N_IN };
struct Args { const float* in[N_IN]; float* out; unsigned char* ws; int ph_lo, ph_hi, coop, pad; };
typedef const __attribute__((address_space(4))) unsigned char* kptr_t;
__device__ __forceinline__ int opaque0() { int z; asm volatile("s_mov_b32 %0, 0" : "=s"(z)); return z; }
#define KIN(i) (*(const float* const __attribute__((address_space(4)))*)(kp + kz + 8 * (i)))

__host__ __device__ __forceinline__ int mix_tile_swap(int t) { return ((t & 12) == 4 || (t & 12) == 8) ? (t ^ 12) : t; }
__device__ __forceinline__ int rowmap(int mode, int n0) {
    if (mode == 1) { const int bj = n0 / FF, j = n0 - bj * FF; return 256 * (j >> 7) + 128 * bj + (j & 127); }
    if (mode == 2) { int r = n0; if (n0 < 2048) { const int bj = n0 >> 10, j = n0 & 1023; r = 256 * (j >> 7) + 128 * bj + (j & 127); } return 256 * mix_tile_swap(r >> 8) + (r & 255); }
    return n0;
}
struct ItemD { const float* W; const float* g; bf16_t* WT; int K, N, mode, it; };
__device__ __forceinline__ void p0_load(const ItemD& d, int lane, f32x4 (&v)[16], float (&gv)[16]) {
    const int nblk = d.N / 64, kb = d.it / nblk, nb = d.it - kb * nblk, k0 = 64 * kb, n0 = 64 * nb, kr = lane >> 4, c4 = lane & 15;
#pragma unroll
    for (int i = 0; i < 16; ++i) v[i] = __builtin_nontemporal_load((const f32x4*)(d.W + (size_t)(k0 + 4 * i + kr) * d.N + n0 + 4 * c4));
#pragma unroll
    for (int i = 0; i < 16; ++i) gv[i] = d.g ? d.g[k0 + 4 * i + kr] : 1.0f;
}
__device__ __forceinline__ void p0_finish(const ItemD& d, int lane, LAS float* scr, const f32x4 (&v)[16], const float (&gv)[16]) {
    const int nblk = d.N / 64, kb = d.it / nblk, nb = d.it - kb * nblk, k0 = 64 * kb, n0 = 64 * nb, kr = lane >> 4, c4 = lane & 15;
    const int drow = rowmap(d.mode, n0);
#pragma unroll
    for (int i = 0; i < 16; ++i) { LAS float* p = scr + (4 * i + kr) * 65 + 4 * c4; const f32x4 x = v[i] * gv[i]; p[0] = x[0]; p[1] = x[1]; p[2] = x[2]; p[3] = x[3]; }
    asm volatile("s_waitcnt lgkmcnt(0)" ::: "memory");
    const int c = lane & 7, nl = lane >> 3;
#pragma unroll
    for (int j = 0; j < 8; ++j) { const int n = nl + 8 * j; const LAS float* s = scr + (8 * c) * 65 + n;
        u32x4 o; o.x = cvt_pk_bf16(s[0 * 65], s[1 * 65]); o.y = cvt_pk_bf16(s[2 * 65], s[3 * 65]); o.z = cvt_pk_bf16(s[4 * 65], s[5 * 65]); o.w = cvt_pk_bf16(s[6 * 65], s[7 * 65]);
        *(u32x4*)(d.WT + (size_t)(drow + n) * d.K + k0 + 8 * c) = o; }
    asm volatile("s_waitcnt lgkmcnt(0)" ::: "memory");
}

template <int J> struct ConvJ { static __device__ __forceinline__ void run(f32x2 (&ov)[16], const f32x2 (&wk)[31], const bf16_t* ABcol, int t0, int tb) {
    const int t = t0 - 30 + J; unsigned v = 0u; if (t >= tb) v = *(const unsigned*)(ABcol + (size_t)t * CCH);
    const f32x2 a = (f32x2){bf_lo(v), bf_hi(v)};
#pragma unroll
    for (int r = 0; r < 16; ++r) { const int k = J - r; if (k >= 0 && k < 31) ov[r] += wk[k] * a; }
    if constexpr (J + 1 < 46) ConvJ<J + 1>::run(ov, wk, ABcol, t0, tb);
} };

__global__ void __launch_bounds__(NTHR, 2) fwd_megakernel(Args args) {
    extern __shared__ __attribute__((aligned(16))) unsigned char lds_raw[];
    LAS unsigned char* lds = (LAS unsigned char*)lds_raw;
    cg::grid_group grid = cg::this_grid();
    const int tid = threadIdx.x, lane = tid & 63, wave = __builtin_amdgcn_readfirstlane(tid >> 6);
    const int G = gridDim.x, bid = blockIdx.x;
    const kptr_t kp = (kptr_t)__builtin_amdgcn_kernarg_segment_ptr();
    const int lo = args.ph_lo, hi = args.ph_hi; const bool coop = args.coop != 0;
    unsigned char* ws = args.ws;
    bf16_t* W1IN = (bf16_t*)(ws + WS_W1IN); bf16_t* W1OUT = (bf16_t*)(ws + WS_W1OUT); bf16_t* W2IN = (bf16_t*)(ws + WS_W2IN); bf16_t* W2OUT = (bf16_t*)(ws + WS_W2OUT);
    bf16_t* WMIXIN = (bf16_t*)(ws + WS_WMIXIN); bf16_t* WMIXOUT = (bf16_t*)(ws + WS_WMIXOUT); bf16_t* WKV = (bf16_t*)(ws + WS_WKV); bf16_t* WO = (bf16_t*)(ws + WS_WO);
    bf16_t* WSGU = (bf16_t*)(ws + WS_WSGU); bf16_t* MEMN = (bf16_t*)(ws + WS_MEMN); bf16_t* KV = (bf16_t*)(ws + WS_KMAT);     bf16_t* VWOT = (bf16_t*)(ws + WS_XR); bf16_t* QKT = (bf16_t*)(ws + WS_XR + 8 * MiB);     bf16_t* WQN = (bf16_t*)(ws + WS_WQ);
    float* PART = (float*)(ws + WS_PART); float* VSTAT = (float*)(ws + WS_VSTAT); bf16_t* XB = (bf16_t*)(ws + WS_XB); bf16_t* ACT = (bf16_t*)(ws + WS_ACT);
    bf16_t* AB = (bf16_t*)(ws + WS_AB); bf16_t* UB = (bf16_t*)(ws + WS_UB); bf16_t* VB = (bf16_t*)(ws + WS_VB); bf16_t* Y = (bf16_t*)(ws + WS_Y);
    bf16_t* P = (bf16_t*)(ws + WS_P);
#define IN(k) (lo <= (k) && (k) < hi)
    volatile LAS unsigned* bst = (volatile LAS unsigned*)(lds + LDS_BYTES - 64);
    if (tid < 16) bst[tid] = 0u;
    __syncthreads();
    XcdBarrier xbar; xbar.bar = (unsigned*)(ws + WS_CTL); xbar.x = 0; xbar.st = bst;
    if (coop) xbar = xcd_barrier_post((unsigned*)(ws + WS_CTL), bst);
    if (args.coop == 2) grid.sync();
#define SEAM(k) do { if (coop && IN(k) && IN((k) + 1)) xcd_barrier(xbar); } while (0)

    if (IN(0)) { const int kz = opaque0();
        LAS float* scr = (LAS float*)(lds + wave * 16640);
        const int gw = bid * NWAVES + wave, NGW = G * NWAVES;
        constexpr int I_FIN = (D / 64) * (2 * FF / 64), I_FOUT = (FF / 64) * (D / 64), I_MIN = (D / 64) * (4096 / 64), I_SQ = (D / 64) * (D / 64), I_KV = (D / 64) * (4096 / 64);
        constexpr int NITEMS = 2 * I_FIN + 2 * I_FOUT + I_MIN + 2 * I_SQ + I_KV;
        const float *w_f1i = KIN(I_FFN1_WIN), *w_f2i = KIN(I_FFN2_WIN), *w_f1o = KIN(I_FFN1_WOUT), *w_f2o = KIN(I_FFN2_WOUT), *w_mi = KIN(I_WMIXIN), *w_mo = KIN(I_WMIXOUT), *w_q = KIN(I_WQ), *w_o = KIN(I_WO), *w_kv = KIN(I_WKV);
        const float *g_f1 = KIN(I_FFN1_NORM), *g_f2 = KIN(I_FFN2_NORM), *g_mi = KIN(I_MIX_NORM), *g_xa = KIN(I_XATTN_NORM);
#define P0_DECODE(r_, d_) do { int r = (r_); \
        if (r < I_FIN) { d_ = ItemD{w_f1i, g_f1, W1IN, D, 2 * FF, 1, r}; break; } r -= I_FIN; \
        if (r < I_KV) { d_ = ItemD{w_kv, nullptr, WKV, D, 4096, 0, r}; break; } r -= I_KV; \
        if (r < I_MIN) { d_ = ItemD{w_mi, g_mi, WMIXIN, D, 4096, 2, r}; break; } r -= I_MIN; \
        if (r < I_SQ) { d_ = ItemD{w_mo, nullptr, WMIXOUT, D, D, 0, r}; break; } r -= I_SQ; \
        if (r < I_SQ) { d_ = ItemD{w_o, nullptr, WO, D, D, 0, r}; break; } r -= I_SQ; \
        if (r < I_FOUT) { d_ = ItemD{w_f1o, nullptr, W1OUT, FF, D, 0, r}; break; } r -= I_FOUT; \
        if (r < I_FIN) { d_ = ItemD{w_f2i, g_f2, W2IN, D, 2 * FF, 1, r}; break; } r -= I_FIN; \
        d_ = ItemD{w_f2o, nullptr, W2OUT, FF, D, 0, r}; } while (0)
        {
            const int nit0 = (G == 256) ? NITEMS - I_FIN - 2 * I_FOUT : NITEMS;
            int it = gw; ItemD dc{}; f32x4 v[16]; float gv[16];
            if (it < nit0) { P0_DECODE(it, dc); p0_load(dc, lane, v, gv); }
            while (it < nit0) {
                const int nx = it + NGW; const bool hn = nx < nit0; ItemD dn{}; f32x4 vn[16]; float gn[16];
                if (hn) { P0_DECODE(nx, dn); p0_load(dn, lane, vn, gn); }
                p0_finish(dc, lane, scr, v, gv);
                if (hn) { dc = dn;
#pragma unroll
                    for (int i = 0; i < 16; ++i) { v[i] = vn[i]; gv[i] = gn[i]; } }
                it = nx;
            }
        }
#undef P0_DECODE
        for (int i0 = bid * NTHR + tid; i0 < D * D / 8; i0 += 4 * G * NTHR) { f32x4 qa[4], qb[4];
#pragma unroll
            for (int r = 0; r < 4; ++r) { const int idx = i0 + r * G * NTHR; if (idx < D * D / 8) { qa[r] = __builtin_nontemporal_load((const f32x4*)(w_q + (size_t)idx * 8)); qb[r] = __builtin_nontemporal_load((const f32x4*)(w_q + (size_t)idx * 8 + 4)); } }
#pragma unroll
            for (int r = 0; r < 4; ++r) { const int idx = i0 + r * G * NTHR; if (idx < D * D / 8) { const float gk = g_xa[idx >> 8]; const f32x4 a = qa[r], b = qb[r];
                u32x4 w; w.x = cvt_pk_bf16(a[0] * gk, a[1] * gk); w.y = cvt_pk_bf16(a[2] * gk, a[3] * gk); w.z = cvt_pk_bf16(b[0] * gk, b[1] * gk); w.w = cvt_pk_bf16(b[2] * gk, b[3] * gk);
                *(u32x4*)(WQN + (size_t)idx * 8) = w; } } }
        for (int m0 = gw; m0 < T; m0 += 4 * NGW) { f32x4 xv[4][8]; const float* xin = KIN(I_X);
#pragma unroll
            for (int r = 0; r < 4; ++r) { const int m = m0 + r * NGW; if (m < T) { const f32x4* xr = (const f32x4*)(xin + (size_t)m * D) + lane;
#pragma unroll
                for (int j = 0; j < 8; ++j) xv[r][j] = __builtin_nontemporal_load(xr + 64 * j); } }
#pragma unroll
            for (int r = 0; r < 4; ++r) { const int m = m0 + r * NGW; if (m < T) { u32x2* o = (u32x2*)(XB + (size_t)m * D) + lane; float s = 0.f;
#pragma unroll
                for (int j = 0; j < 8; ++j) { const f32x4 v = xv[r][j]; s += (v[0] * v[0] + v[1] * v[1]) + (v[2] * v[2] + v[3] * v[3]); u32x2 w; w.x = cvt_pk_bf16(v[0], v[1]); w.y = cvt_pk_bf16(v[2], v[3]); o[64 * j] = w; }
                s += __shfl_xor(s, 32); if (lane < 32) PART[(size_t)m * NPART + lane] = s; } }
        }
        for (int m = gw; m < 2 * NMEM; m += NGW) {
            const f32x4* xr = (const f32x4*)(KIN(I_MEM) + (size_t)m * D) + lane; const f32x4* gr = (const f32x4*)KIN(I_MEM_NORM) + lane; u32x2* o = (u32x2*)(MEMN + (size_t)m * D) + lane;
            f32x4 v[8]; float s = 0.f;
#pragma unroll
            for (int j = 0; j < 8; ++j) { v[j] = xr[64 * j]; s += (v[j][0] * v[j][0] + v[j][1] * v[j][1]) + (v[j][2] * v[j][2] + v[j][3] * v[j][3]); }
            const float rstd = rsqrtf(wave_sum(s) * (1.0f / D) + RMS_EPS);
#pragma unroll
            for (int j = 0; j < 8; ++j) { const f32x4 gg = gr[64 * j]; const f32x4 y = v[j] * rstd * gg; u32x2 w; w.x = cvt_pk_bf16(y[0], y[1]); w.y = cvt_pk_bf16(y[2], y[3]); o[64 * j] = w; }
        }
        for (int idx = bid * NTHR + tid; idx < 8 * 128 * 128; idx += G * NTHR) { const int i = (idx >> 7) & 127, j = idx & 127; const float w = ((j >> 6) <= (i >> 6)) ? KIN(I_SGU_W)[idx] : 0.f;
            WSGU[idx] = (bf16_t)(cvt_pk_bf16(w, 0.f) & 0xffffu); }
    }
    SEAM(0);

    if (IN(1)) { const int kz = opaque0();
        unsigned* kvcnt = (unsigned*)(ws + WS_CTL) + 6400;
        { pg8::Gemm g{MEMN, WKV, D, D, D}; pg8::PlainOrder S; S.init(2 * NMEM, 2 * D, G, (bid + G - G / 2) % G, D, D); pg8::EpiBf16Pub E{KV, 2 * D, kvcnt};
          pg8::gemm_phase<pg8::EpiBf16Pub, pg8::PlainOrder, true>(lds, g, S, E); }
        { pg8::Gemm g{XB, W1IN, D, D, D}; pg8::PlainOrder S; S.init(T, 2 * FF, G, bid, D, D); pg8::EpiSwiGLU E{ACT, PART};
          pg8::gemm_phase<pg8::EpiSwiGLU, pg8::PlainOrder, true>(lds, g, S, E); }
        for (int v = (bid + G - (160 % G)) % G; v < 64; v += G) { const int b = v >> 5, h = (v >> 3) & 3, nt = v & 7;
            if (tid < 64) { unsigned sp = 0; while ((unsigned)__builtin_amdgcn_readfirstlane(__hip_atomic_load(kvcnt, __ATOMIC_RELAXED, __HIP_MEMORY_SCOPE_AGENT)) < 256u) { __builtin_amdgcn_s_sleep(8); if (++sp > (1u << 20)) break; } }
            __syncthreads(); __builtin_amdgcn_fence(__ATOMIC_ACQUIRE, "agent"); asm volatile("s_waitcnt vmcnt(0)" ::: "memory");
            pg8::OneUnit S; S.u.pm = h; S.u.pn = nt; S.u.aoff = (unsigned)(b * 256) * (2 * D) + h * 512; S.u.boff = (unsigned)(nt * 256) * D + h * 512;
            pg8::Gemm g{KV, WQN, 2 * D, D, 512 + kz}; pg8::EpiBf16S E{QKT + (size_t)b * 1024 * D, D, nullptr, 1.0f};
            pg8::gemm_phase<pg8::EpiBf16S, pg8::OneUnit, false>(lds, g, S, E); }
        if (G == 256 && bid >= 160) {
            LAS float* scr = (LAS float*)(lds + wave * 16640); const int gw = (bid - 160) * NWAVES + wave, NGW = 96 * NWAVES;
            constexpr int NIT = (FF / 64) * (D / 64); const float* w_f1o = KIN(I_FFN1_WOUT);
#define P1_DECODE(r_, d_) do { d_ = ItemD{w_f1o, nullptr, W1OUT, FF, D, 0, (r_)}; } while (0)
            int it = gw; ItemD dc{}; f32x4 v[16]; float gv[16];
            if (it < NIT) { P1_DECODE(it, dc); p0_load(dc, lane, v, gv); }
            while (it < NIT) {
                const int nx = it + NGW; const bool hn = nx < NIT; ItemD dn{}; f32x4 vn[16]; float gn[16];
                if (hn) { P1_DECODE(nx, dn); p0_load(dn, lane, vn, gn); }
                p0_finish(dc, lane, scr, v, gv);
                if (hn) { dc = dn;
#pragma unroll
                    for (int i = 0; i < 16; ++i) { v[i] = vn[i]; gv[i] = gn[i]; } }
                it = nx;
            }
#undef P1_DECODE
        }
    }
    SEAM(1);

    if (IN(2)) { const int kz = opaque0();
        pg8::Gemm g{ACT, W1OUT, FF, FF, FF}; pg8::PlainOrder S; S.init(T, D, G, bid, FF, FF); pg8::EpiResid E{XB, PART, 0.5f};
        pg8::gemm_phase<pg8::EpiResid, pg8::PlainOrder, true>(lds, g, S, E);
    }
    SEAM(2);

    if (IN(3)) { const int kz = opaque0();
        pg8::Gemm g{XB, WMIXIN, D, D, D}; pg8::MixOrder S; S.init(T, 4096, G, bid, D, D); pg8::EpiMixIn E{AB, UB, VB, VSTAT, PART};
        pg8::gemm_phase<pg8::EpiMixIn, pg8::MixOrder, true>(lds, g, S, E);
    }
    SEAM(3);

    if (IN(4)) { const int kz = opaque0();
        for (int cu = bid; cu < T / 32; cu += G) {
            const int t0 = cu * 32, tb = (t0 / SEQ) * SEQ;
            f32x2 wk[31];
#pragma unroll
            for (int k = 0; k < 31; ++k) wk[k] = *(const f32x2*)(KIN(I_CONV_W) + k * CCH + 2 * tid);
            const f32x2 cb = *(const f32x2*)(KIN(I_CONV_B) + 2 * tid);
            LAS float* Os = (LAS float*)lds;
#pragma unroll 1
            for (int hf = 0; hf < 2; ++hf) {
                f32x2 ov[16];
#pragma unroll
                for (int r = 0; r < 16; ++r) ov[r] = cb;
                ConvJ<0>::run(ov, wk, AB + 2 * tid, t0 + 16 * hf, tb);
#pragma unroll
                for (int r = 0; r < 16; ++r) *(LAS f32x2*)(Os + (16 * hf + r) * CCH + 2 * tid) = ov[r];
            }
            __syncthreads();
#pragma unroll
            for (int rr = 0; rr < 4; ++rr) { const int r = wave * 4 + rr; f32x4 x[4]; float s = 0.f;
#pragma unroll
                for (int j = 0; j < 4; ++j) { x[j] = *(const LAS f32x4*)(Os + r * CCH + j * 256 + 4 * lane); s += (x[j][0] + x[j][1]) + (x[j][2] + x[j][3]); }
                const float mean = wave_sum(s) * (1.0f / CCH); float q = 0.f;
#pragma unroll
                for (int j = 0; j < 4; ++j) { x[j] = x[j] - mean; q += (x[j][0] * x[j][0] + x[j][1] * x[j][1]) + (x[j][2] * x[j][2] + x[j][3] * x[j][3]); }
                const float rstd = rsqrtf(wave_sum(q) * (1.0f / CCH) + LN_EPS); float z2 = 0.f;
#pragma unroll
                for (int j = 0; j < 4; ++j) { const f32x4 gg = *(const f32x4*)(KIN(I_CONV_LN_G) + j * 256 + 4 * lane), bb = *(const f32x4*)(KIN(I_CONV_LN_B) + j * 256 + 4 * lane);
                    f32x4 y = x[j] * rstd * gg + bb;
#pragma unroll
                    for (int e = 0; e < 4; ++e) { y[e] = y[e] * sigmoidf_(y[e]); z2 += y[e] * y[e]; }
                    x[j] = y; }
                const float r2 = rsqrtf(wave_sum(z2) * (1.0f / CCH) + RMS_EPS);
#pragma unroll
                for (int j = 0; j < 4; ++j) { const f32x4 gg = *(const f32x4*)(KIN(I_OUT_NORM_CONV) + j * 256 + 4 * lane); const f32x4 y = x[j] * r2 * gg;
                    u32x2 w; w.x = cvt_pk_bf16(y[0], y[1]); w.y = cvt_pk_bf16(y[2], y[3]); *(u32x2*)(Y + (size_t)(t0 + r) * D + j * 256 + 4 * lane) = w; }
            }
            __syncthreads();
        }
        for (int su = bid; su < T / 32; su += G) {
            const int tc0 = (su >> 2) * 128, qi = su & 3, i0 = 32 * qi, J = qi < 2 ? 64 : 128;
            constexpr int LDB = 136;
            LAS bf16_t* Bt = (LAS bf16_t*)lds;
            LAS f32x2* st = (LAS f32x2*)(lds + 2 * 128 * LDB * 2);
            LAS float* red = (LAS float*)(lds + 2 * 128 * LDB * 2 + 1024);
            if (tid < J) { const f32x4* p = (const f32x4*)(VSTAT + (size_t)(tc0 + tid) * 32); float s1 = 0.f, s2 = 0.f;
#pragma unroll
                for (int j = 0; j < 8; ++j) { const f32x4 v = p[j]; s1 += v[0] + v[2]; s2 += v[1] + v[3]; }
                const float mean = s1 * (1.0f / CCH), var = fmaxf(s2 * (1.0f / CCH) - mean * mean, 0.f); st[tid] = (f32x2){mean, rsqrtf(var + LN_EPS)}; }
            const int mb = wave & 1, nq = wave >> 1, fr = lane & 15, fq = lane >> 4;
            const int trow = tc0 + i0 + 16 * mb + fr;
            const float* lng = KIN(I_SGU_LN_G); const float* lnb = KIN(I_SGU_LN_B); const float* sgb = KIN(I_SGU_B);
            const int c8 = tid & 15, jb = tid >> 4, nk = J / 32;
            u32x4 pv[4]; f32x4 pg0, pg1, pb0, pb1; bf16x8 pw[4]; u32x2 pu0, pu1; float pbs;
#define SGU_PREFETCH(h_) do { \
    _Pragma("unroll") for (int k = 0; k < 4; ++k) if (k < nk) pv[k] = *(const u32x4*)(VB + (size_t)(tc0 + jb + 32 * k) * CCH + (h_) * 128 + c8 * 8); \
    pg0 = *(const f32x4*)(lng + (h_) * 128 + c8 * 8); pg1 = *(const f32x4*)(lng + (h_) * 128 + c8 * 8 + 4); pb0 = *(const f32x4*)(lnb + (h_) * 128 + c8 * 8); pb1 = *(const f32x4*)(lnb + (h_) * 128 + c8 * 8 + 4); \
    _Pragma("unroll") for (int ks = 0; ks < 4; ++ks) if (ks < nk) pw[ks] = *(const bf16x8*)(WSGU + (size_t)(h_) * 16384 + (i0 + 16 * mb + fr) * 128 + ks * 32 + fq * 8); \
    pbs = sgb[(h_) * 128 + i0 + 16 * mb + fr]; \
    pu0 = *(const u32x2*)(UB + (size_t)trow * CCH + (h_) * 128 + 32 * nq + 4 * fq); pu1 = *(const u32x2*)(UB + (size_t)trow * CCH + (h_) * 128 + 32 * nq + 4 * fq + 16); } while (0)
            f32x4 yv[8][2]; float ss = 0.f;
            SGU_PREFETCH(0);
            __syncthreads();
#pragma unroll
            for (int h = 0; h < 8; ++h) {
                LAS bf16_t* Bc = Bt + (h & 1) * (128 * LDB);
#pragma unroll
                for (int k = 0; k < 4; ++k) if (k < nk) { const int j = jb + 32 * k; const u32x4 v = pv[k]; const f32x2 ms = st[j];
                    const f32x4 x0 = (f32x4){bf_lo(v.x), bf_hi(v.x), bf_lo(v.y), bf_hi(v.y)}, x1 = (f32x4){bf_lo(v.z), bf_hi(v.z), bf_lo(v.w), bf_hi(v.w)};
                    const f32x4 y0 = (x0 - ms.x) * ms.y * pg0 + pb0, y1 = (x1 - ms.x) * ms.y * pg1 + pb1;
                    LAS bf16_t* d = Bc + (c8 * 8) * LDB + (j ^ (8 * c8));
                    const unsigned p0 = cvt_pk_bf16(y0[0], y0[1]), p1 = cvt_pk_bf16(y0[2], y0[3]), p2 = cvt_pk_bf16(y1[0], y1[1]), p3 = cvt_pk_bf16(y1[2], y1[3]);
                    d[0 * LDB] = (bf16_t)(p0 & 0xffffu); d[1 * LDB] = (bf16_t)(p0 >> 16); d[2 * LDB] = (bf16_t)(p1 & 0xffffu); d[3 * LDB] = (bf16_t)(p1 >> 16);
                    d[4 * LDB] = (bf16_t)(p2 & 0xffffu); d[5 * LDB] = (bf16_t)(p2 >> 16); d[6 * LDB] = (bf16_t)(p3 & 0xffffu); d[7 * LDB] = (bf16_t)(p3 >> 16); }
                bf16x8 cw[4];
#pragma unroll
                for (int ks = 0; ks < 4; ++ks) cw[ks] = pw[ks];
                const u32x2 u0 = pu0, u1 = pu1; const float bs = pbs;
                __syncthreads();
                if (h + 1 < 8) SGU_PREFETCH(h + 1);
                f32x4 a0 = (f32x4){0.f, 0.f, 0.f, 0.f}, a1 = a0;
#pragma unroll
                for (int ks = 0; ks < 4; ++ks) if (ks < nk) {
                    const int r0 = 16 * (2 * nq) + fr, r1 = r0 + 16, q = ks * 4 + fq;
                    const bf16x8 x0 = *(const LAS bf16x8*)(Bc + r0 * LDB + ((q ^ ((r0 >> 3) & 15)) * 8)), x1 = *(const LAS bf16x8*)(Bc + r1 * LDB + ((q ^ ((r1 >> 3) & 15)) * 8));
                    a0 = __builtin_amdgcn_mfma_f32_16x16x32_bf16(x0, cw[ks], a0, 0, 0, 0); a1 = __builtin_amdgcn_mfma_f32_16x16x32_bf16(x1, cw[ks], a1, 0, 0, 0);
                }
                const f32x4 uu0 = (f32x4){bf_lo(u0.x), bf_hi(u0.x), bf_lo(u0.y), bf_hi(u0.y)}, uu1 = (f32x4){bf_lo(u1.x), bf_hi(u1.x), bf_lo(u1.y), bf_hi(u1.y)};
                const f32x4 y0 = uu0 * (a0 + bs), y1 = uu1 * (a1 + bs);
                ss += ((y0[0] * y0[0] + y0[1] * y0[1]) + (y0[2] * y0[2] + y0[3] * y0[3])) + ((y1[0] * y1[0] + y1[1] * y1[1]) + (y1[2] * y1[2] + y1[3] * y1[3]));
                yv[h][0] = y0; yv[h][1] = y1;
            }
#undef SGU_PREFETCH
            ss += __shfl_xor(ss, 16); ss += __shfl_xor(ss, 32);
            if (fq == 0) red[(mb * 4 + nq) * 16 + fr] = ss;
            __syncthreads();
            const float tot = (red[(mb * 4 + 0) * 16 + fr] + red[(mb * 4 + 1) * 16 + fr]) + (red[(mb * 4 + 2) * 16 + fr] + red[(mb * 4 + 3) * 16 + fr]);
            const float r2 = rsqrtf(tot * (1.0f / CCH) + RMS_EPS);
#pragma unroll
            for (int h = 0; h < 8; ++h)
#pragma unroll
                for (int nb = 0; nb < 2; ++nb) { const int ch = h * 128 + 32 * nq + 16 * nb + 4 * fq; const f32x4 gg = *(const f32x4*)(KIN(I_OUT_NORM_SGU) + ch); const f32x4 y = yv[h][nb] * r2 * gg;
                    u32x2 w; w.x = cvt_pk_bf16(y[0], y[1]); w.y = cvt_pk_bf16(y[2], y[3]); *(u32x2*)(Y + (size_t)trow * D + CCH + ch) = w; }
            __syncthreads();
        }
    }
    SEAM(4);

    if (IN(5)) { const int kz = opaque0();
        pg8::Gemm g{Y, WMIXOUT, D, D, D}; pg8::PlainOrder S; S.init(T, D, G, bid, D, D); pg8::EpiResid E{XB, PART, 1.0f};
        pg8::gemm_phase<pg8::EpiResid, pg8::PlainOrder, true>(lds, g, S, E);
    }
    SEAM(5);

    if (IN(6)) { const int kz = opaque0();
        for (int L = bid; L < 128; L += G) { const int h = L & 3, pm = L >> 2;
            pg8::OneUnit S; S.u.pm = pm; S.u.pn = h; S.u.aoff = (unsigned)pm * 256 * D; S.u.boff = (unsigned)((pm >> 4) * 1024 + h * 256) * D;
            pg8::Gemm g{XB, QKT, D, D, D + kz}; pg8::EpiSoftmax E{P, PART, 0.044194173824159216f * 1.4426950408889634f};
            pg8::gemm_phase<pg8::EpiSoftmax, pg8::OneUnit, false>(lds, g, S, E); }
        for (int v = (bid + G - (128 % G)) % G; v < 64; v += G) { const int b = v >> 5, h = (v >> 3) & 3, nt = v & 7;
            pg8::OneUnit S; S.u.pm = nt; S.u.pn = h; S.u.aoff = (unsigned)nt * 256 * D + h * 512; S.u.boff = (unsigned)(b * 256) * (2 * D) + D + h * 512;
            pg8::Gemm g{WO, KV, D, 2 * D, 512 + kz}; pg8::EpiBf16S E{VWOT + (size_t)b * D * 1024, 1024, nullptr, 1.0f};
            pg8::gemm_phase<pg8::EpiBf16S, pg8::OneUnit, false>(lds, g, S, E); }
        if (G == 256 && bid >= 128) {
            constexpr int I_FIN = (D / 64) * (2 * FF / 64), N_A = 2432;
            const bool grpB = bid >= 192; const int NGW = 64 * NWAVES, gw = ((bid - 128) & 63) * NWAVES + wave, NIT = grpB ? I_FIN : N_A;
            LAS float* scr = (LAS float*)(lds + wave * 16640);
            const float *w_f2i = KIN(I_FFN2_WIN), *g_f2 = KIN(I_FFN2_NORM);
#define P6_DECODE(r_, d_) do { d_ = ItemD{w_f2i, g_f2, W2IN, D, 2 * FF, 1, (r_)}; } while (0)
            int it = (grpB ? N_A : 0) + gw; ItemD dc{}; f32x4 v[16]; float gv[16];
            if (it < NIT) { P6_DECODE(it, dc); p0_load(dc, lane, v, gv); }
            while (it < NIT) {
                const int nx = it + NGW; const bool hn = nx < NIT; ItemD dn{}; f32x4 vn[16]; float gn[16];
                if (hn) { P6_DECODE(nx, dn); p0_load(dn, lane, vn, gn); }
                p0_finish(dc, lane, scr, v, gv);
                if (hn) { dc = dn;
#pragma unroll
                    for (int i = 0; i < 16; ++i) { v[i] = vn[i]; gv[i] = gn[i]; } }
                it = nx;
            }
#undef P6_DECODE
        }
    }
    SEAM(6);

    if (IN(8) && !IN(7)) { }

    if (IN(9)) { const int kz = opaque0();
        pg8::Gemm g{P, VWOT, 1024, 1024, 1024 + kz}; pg8::BatchBOrder S; S.init(T, D, G, bid, 1024, 1024, (unsigned)D * 1024); pg8::EpiResid E{XB, PART, 1.0f};
        pg8::gemm_phase<pg8::EpiResid, pg8::BatchBOrder, true>(lds, g, S, E);
    }
    SEAM(9);

    if (IN(10)) { const int kz = opaque0();
        pg8::Gemm g{XB, W2IN, D, D, D}; pg8::PlainOrder S; S.init(T, 2 * FF, G, bid, D, D); pg8::EpiSwiGLU E{ACT, PART};
        pg8::gemm_phase<pg8::EpiSwiGLU, pg8::PlainOrder, true>(lds, g, S, E);
        if (G == 256 && bid >= 128) {
            LAS float* scr = (LAS float*)(lds + wave * 16640); const int gw = (bid - 128) * NWAVES + wave, NGW = 128 * NWAVES;
            constexpr int NIT = (FF / 64) * (D / 64); const float* w_f2o = KIN(I_FFN2_WOUT);
#define P10_DECODE(r_, d_) do { d_ = ItemD{w_f2o, nullptr, W2OUT, FF, D, 0, (r_)}; } while (0)
            int it = gw; ItemD dc{}; f32x4 v[16]; float gv[16];
            if (it < NIT) { P10_DECODE(it, dc); p0_load(dc, lane, v, gv); }
            while (it < NIT) {
                const int nx = it + NGW; const bool hn = nx < NIT; ItemD dn{}; f32x4 vn[16]; float gn[16];
                if (hn) { P10_DECODE(nx, dn); p0_load(dn, lane, vn, gn); }
                p0_finish(dc, lane, scr, v, gv);
                if (hn) { dc = dn;
#pragma unroll
                    for (int i = 0; i < 16; ++i) { v[i] = vn[i]; gv[i] = gn[i]; } }
                it = nx;
            }
#undef P10_DECODE
        }
    }
    SEAM(10);

    if (IN(11)) { const int kz = opaque0();
        pg8::Gemm g{ACT, W2OUT, FF, FF, FF}; pg8::PlainOrder S; S.init(T, D, G, bid, FF, FF);
        if (G == 256 && coop) {
            pg8::EpiFinal E{XB, PART, (unsigned*)(ws + WS_CTL) + 4096, KIN(I_FINAL_NORM), args.out, 0.5f, (LAS float*)(lds + RING_BYTES + 2048)};
            pg8::gemm_phase<pg8::EpiFinal, pg8::PlainOrder, true>(lds, g, S, E);
        } else {
            pg8::EpiResid E{XB, PART, 0.5f};
            pg8::gemm_phase<pg8::EpiResid, pg8::PlainOrder, true>(lds, g, S, E);
        }
    }
    if (!(G == 256 && coop)) SEAM(11);

    if (IN(12) && !(G == 256 && coop)) { const int kz = opaque0();
        const int gw = bid * NWAVES + wave, NGW = G * NWAVES;
        for (int m = gw; m < T; m += NGW) {
            const u32x4* xr = (const u32x4*)(XB + (size_t)m * D) + lane; const float* gr = KIN(I_FINAL_NORM); float* o = args.out + (size_t)m * D;
            f32x4 v[8]; float s = 0.f;
#pragma unroll
            for (int j = 0; j < 4; ++j) { const u32x4 r = xr[64 * j]; v[2 * j] = (f32x4){bf_lo(r.x), bf_hi(r.x), bf_lo(r.y), bf_hi(r.y)}; v[2 * j + 1] = (f32x4){bf_lo(r.z), bf_hi(r.z), bf_lo(r.w), bf_hi(r.w)};
                s += ((v[2 * j][0] * v[2 * j][0] + v[2 * j][1] * v[2 * j][1]) + (v[2 * j][2] * v[2 * j][2] + v[2 * j][3] * v[2 * j][3])) + ((v[2 * j + 1][0] * v[2 * j + 1][0] + v[2 * j + 1][1] * v[2 * j + 1][1]) + (v[2 * j + 1][2] * v[2 * j + 1][2] + v[2 * j + 1][3] * v[2 * j + 1][3])); }
            const float rstd = rsqrtf(wave_sum(s) * (1.0f / D) + RMS_EPS);
#pragma unroll
            for (int j = 0; j < 4; ++j) { const int c = 512 * j + 8 * lane; const f32x4 g0 = *(const f32x4*)(gr + c), g1 = *(const f32x4*)(gr + c + 4);
                *(f32x4*)(o + c) = v[2 * j] * rstd * g0; *(f32x4*)(o + c + 4) = v[2 * j + 1] * rstd * g1; }
        }
    }
#undef IN
#undef SEAM
}

extern "C" void kernel_launch(void* const* d_in, const int* in_sizes, int n_in, void* d_out, int out_size, void* d_ws, size_t ws_size, hipStream_t stream) {
    static int grid = 0;
    if (grid == 0) {
        if (n_in != N_IN || in_sizes[0] != T * D || out_size != T * D || ws_size < WS_END) {
            fprintf(stderr, "kernel_launch: unexpected problem (n_in %d, in0 %d, out %d, ws %zu; need ws >= %zu); nothing launched\n", n_in, n_in > 0 ? in_sizes[0] : -1, out_size, ws_size, (size_t)WS_END); grid = -1; return; }
        int dev = 0, cus = 0, per_cu = 0;
        if (hipGetDevice(&dev) != hipSuccess || hipDeviceGetAttribute(&cus, hipDeviceAttributeMultiprocessorCount, dev) != hipSuccess) { fprintf(stderr, "kernel_launch: device query failed\n"); grid = -1; return; }
        if (hipFuncSetAttribute((const void*)fwd_megakernel, hipFuncAttributeMaxDynamicSharedMemorySize, LDS_BYTES) != hipSuccess) { fprintf(stderr, "kernel_launch: hipFuncSetAttribute failed\n"); grid = -1; return; }
        if (hipOccupancyMaxActiveBlocksPerMultiprocessor(&per_cu, (const void*)fwd_megakernel, NTHR, LDS_BYTES) != hipSuccess || per_cu < 1) { fprintf(stderr, "kernel_launch: occupancy query says %d\n", per_cu); per_cu = 1; }
        (void)hipGetLastError();
        grid = cus * per_cu;
        fprintf(stderr, "kernel_launch: grid %d (cus %d x %d)\n", grid, cus, per_cu);
    }
    if (grid < 0) return;
    Args a{};
    for (int i = 0; i < N_IN; ++i) a.in[i] = (const float*)d_in[i];
    a.out = (float*)d_out; a.ws = (unsigned char*)d_ws;
    if (hipMemsetAsync((char*)d_ws + WS_CTL, 0, CTL_ZERO_BYTES, stream) != hipSuccess) { fprintf(stderr, "kernel_launch: memset of the control words failed\n"); return; }
#if MK_MULTI
    for (int ph = 0; ph < NPHASE; ++ph) for (int rep = 0; rep < (((MK_PROBE_MASK >> ph) & 1) ? 2 : 1); ++rep) { a.ph_lo = ph; a.ph_hi = ph + 1; a.coop = 0;
        hipLaunchKernelGGL(fwd_megakernel, dim3(grid), dim3(NTHR), LDS_BYTES, stream, a);
        const hipError_t le = hipPeekAtLastError(); if (le != hipSuccess) { fprintf(stderr, "kernel_launch: launch %d failed: %s\n", ph, hipGetErrorName(le)); break; } }
#else
    a.ph_lo = 0; a.ph_hi = NPHASE; a.coop = 1;
    void* kargs[] = {&a};
    const hipError_t e = hipLaunchCooperativeKernel((const void*)fwd_megakernel, dim3(grid), dim3(NTHR), kargs, LDS_BYTES, stream);
    if (e != hipSuccess) fprintf(stderr, "kernel_launch: cooperative launch failed: %s (grid %d)\n", hipGetErrorString(e), grid);
#endif
}
```
